# Optimizing an MI355X kernel written in HIP

```python
import math
import jax, jax.numpy as jnp
from jax import lax
import numpy as np

D_MODEL = 1024
BATCH = 4
SEQ = 8192
DEPTH = 4

N_MIXERS = 2
EPS = 1e-6

ML_HEADS = 4
ML_QK_DIM = D_MODEL // 2 // ML_HEADS
ML_V_DIM = D_MODEL // ML_HEADS
ML_QK = ML_HEADS * ML_QK_DIM
ML_V = ML_HEADS * ML_V_DIM
ML_IN = 2 * ML_QK + 2 * ML_V + 2 * ML_HEADS
ML_CHUNK = 64
GATE_CAP = 15.0

SW_Q_HEADS = 16
SW_KV_HEADS = 4
SW_GROUP = SW_Q_HEADS // SW_KV_HEADS
SW_HEAD_DIM = 64
WINDOW = 128
SW_IN = (SW_Q_HEADS + 2 * SW_KV_HEADS) * SW_HEAD_DIM
SW_OUT_IN = SW_Q_HEADS * SW_HEAD_DIM

N_GROUPS = 8
EXPERTS_PER_GROUP = 8
N_EXPERTS = N_GROUPS * EXPERTS_PER_GROUP
TOP_K = 2
D_EXPERT = 384
MOE_BLOCK = 256

kernel_name = "hybrid_mlstm_swa_hmoe_adaln"


def rmsnorm(x, g):
    xf = x.astype(jnp.float32)
    y = xf * lax.rsqrt(jnp.mean(xf * xf, axis=-1, keepdims=True) + EPS)
    return y.astype(x.dtype) * g


def softcap(z):
    return GATE_CAP * jnp.tanh(z / GATE_CAP)


def mlstm_mixer(h, w_in, b_gate, g_out, w_out):
    B, S, _ = h.shape
    H, dk, dv, L = ML_HEADS, ML_QK_DIM, ML_V_DIM, ML_CHUNK
    NC = S // L
    proj = h @ w_in
    q, k, v, o, gates = jnp.split(proj, [ML_QK, 2 * ML_QK, 2 * ML_QK + ML_V, 2 * ML_QK + 2 * ML_V], axis=-1)
    gates = softcap(gates.astype(jnp.float32) + b_gate)
    i_pre = gates[..., :H]
    log_f = jax.nn.log_sigmoid(gates[..., H:])

    def to_chunks(t, d):
        return t.astype(jnp.float32).reshape(B, NC, L, H, d).transpose(1, 0, 3, 2, 4)

    def gate_chunks(t):
        return t.reshape(B, NC, L, H).transpose(1, 0, 3, 2)

    qc = to_chunks(q, dk)
    kc = to_chunks(k, dk) * (dk ** -0.5)
    vc = to_chunks(v, dv)
    ic = gate_chunks(i_pre)
    fc = gate_chunks(log_f)
    causal = jnp.tril(jnp.ones((L, L), dtype=bool))

    def step(carry, inp):
        C, n, m = carry
        qb, kb, vb, ib, fb = inp
        b = jnp.cumsum(fb, axis=-1)
        d_log = jnp.where(causal, b[..., :, None] - b[..., None, :] + ib[..., None, :], -jnp.inf)
        inter = b + m[..., None]
        m_t = jnp.maximum(inter, d_log.max(-1))
        w_intra = jnp.exp(d_log - m_t[..., None])
        w_inter = jnp.exp(inter - m_t)
        s = jnp.einsum('bhtd,bhsd->bhts', qb, kb) * w_intra
        num = w_inter[..., None] * jnp.einsum('bhtd,bhdv->bhtv', qb, C) + jnp.einsum('bhts,bhsv->bhtv', s, vb)
        den = w_inter * jnp.einsum('bhtd,bhd->bht', qb, n) + s.sum(-1)
        hb = num / jnp.maximum(jnp.abs(den), jnp.exp(-m_t))[..., None]
        g = b[..., -1]
        a = g[..., None] - b + ib
        m_new = jnp.maximum(g + m, a.max(-1))
        w_state = jnp.exp(a - m_new[..., None])
        decay = jnp.exp(g + m - m_new)
        C_new = decay[..., None, None] * C + jnp.einsum('bhs,bhsd,bhsv->bhdv', w_state, kb, vb)
        n_new = decay[..., None] * n + jnp.einsum('bhs,bhsd->bhd', w_state, kb)
        return (C_new, n_new, m_new), hb

    init = (jnp.zeros((B, H, dk, dv), jnp.float32), jnp.zeros((B, H, dk), jnp.float32), jnp.zeros((B, H), jnp.float32))
    _, hs = lax.scan(step, init, (qc, kc, vc, ic, fc))
    hs = hs.transpose(1, 0, 3, 2, 4).reshape(B, S, H, dv)
    hs = rmsnorm(hs, g_out.reshape(H, dv)).astype(h.dtype)
    hs = hs * jax.nn.sigmoid(o).reshape(B, S, H, dv)
    return hs.reshape(B, S, ML_V) @ w_out


def swa_mixer(h, w_in, g_q, g_k, sinks, w_out):
    B, S, _ = h.shape
    W, dh = WINDOW, SW_HEAD_DIM
    NB = S // W
    proj = h @ w_in
    q, k, v = jnp.split(proj, [SW_Q_HEADS * dh, (SW_Q_HEADS + SW_KV_HEADS) * dh], axis=-1)
    q = rmsnorm(q.reshape(B, S, SW_Q_HEADS, dh), g_q)
    k = rmsnorm(k.reshape(B, S, SW_KV_HEADS, dh), g_k)
    v = v.reshape(B, S, SW_KV_HEADS, dh)
    qb = q.reshape(B, NB, W, SW_KV_HEADS, SW_GROUP, dh)

    def band(t):
        tb = t.reshape(B, NB, W, SW_KV_HEADS, dh)
        prev = jnp.concatenate([jnp.zeros_like(tb[:, :1]), tb[:, :-1]], axis=1)
        return jnp.concatenate([prev, tb], axis=2)

    kb, vb = band(k), band(v)
    scores = jnp.einsum('bnqhgd,bnkhd->bnhgqk', qb, kb).astype(jnp.float32) * (dh ** -0.5)
    qi = jnp.arange(W)[:, None]
    ki = jnp.arange(2 * W)[None, :]
    rel = qi + W - ki
    in_win = (rel >= 0) & (rel < W)
    first = (jnp.arange(NB)[:, None, None] == 0) & (ki[None] < W)
    mask = in_win[None] & ~first
    scores = jnp.where(mask[None, :, None, None], scores, -jnp.inf)
    sink = sinks.astype(jnp.float32).reshape(SW_KV_HEADS, SW_GROUP)[None, None, :, :, None]
    m = jnp.maximum(scores.max(-1), sink)
    p = jnp.exp(scores - m[..., None])
    denom = p.sum(-1) + jnp.exp(sink - m)
    p = (p / denom[..., None]).astype(v.dtype)
    o = jnp.einsum('bnhgqk,bnkhd->bnqhgd', p, vb)
    return o.reshape(B, S, SW_OUT_IN) @ w_out


def hier_moe(h, w_group, b_group, w_router, b_router, w1, w3, w2):
    B, S, D = h.shape
    T = B * S
    A = T * TOP_K
    xt = h.reshape(T, D)
    grp_logits = (xt @ w_group + b_group).astype(jnp.float32)
    g_sel = jnp.argmax(grp_logits, axis=-1)
    p_grp = jnp.take_along_axis(jax.nn.softmax(grp_logits, axis=-1), g_sel[:, None], axis=-1)
    exp_logits = (xt @ w_router + b_router).astype(jnp.float32).reshape(T, N_GROUPS, EXPERTS_PER_GROUP)
    in_grp = jnp.take_along_axis(exp_logits, g_sel[:, None, None], axis=1)[:, 0]
    top_v, top_i = lax.top_k(in_grp, TOP_K)
    gate = jax.nn.softmax(top_v, axis=-1) * p_grp
    e_idx = (g_sel[:, None] * EXPERTS_PER_GROUP + top_i).reshape(A).astype(jnp.int32)
    tok = jnp.repeat(jnp.arange(T, dtype=jnp.int32), TOP_K)

    order = jnp.argsort(e_idx, stable=True)
    se = e_idx[order]
    counts = jnp.bincount(e_idx, length=N_EXPERTS)
    starts = jnp.cumsum(counts) - counts
    padded = (counts + MOE_BLOCK - 1) // MOE_BLOCK * MOE_BLOCK
    pad_ends = jnp.cumsum(padded)
    pad_starts = pad_ends - padded
    dest = pad_starts[se] + jnp.arange(A, dtype=jnp.int32) - starts[se]
    NB = -(-A // MOE_BLOCK) + N_EXPERTS
    P = NB * MOE_BLOCK
    slot_tok = jnp.full((P,), T, dtype=jnp.int32).at[dest].set(tok[order])
    slot_w = jnp.zeros((P,), jnp.float32).at[dest].set(gate.reshape(A)[order])
    blk_exp = jnp.minimum(jnp.searchsorted(pad_ends, jnp.arange(NB, dtype=jnp.int32) * MOE_BLOCK, side='right'), N_EXPERTS - 1)
    x_slots = jnp.concatenate([xt, jnp.zeros((1, D), xt.dtype)], axis=0)[slot_tok].reshape(NB, MOE_BLOCK, D)

    def expert_block(args):
        xb, e = args
        return (jax.nn.silu(xb @ w1[e]) * (xb @ w3[e])) @ w2[e]

    y_slots = lax.map(expert_block, (x_slots, blk_exp)).reshape(P, D)
    y = jnp.zeros((T + 1, D), h.dtype).at[slot_tok].add(y_slots * slot_w[:, None].astype(h.dtype))
    return y[:T].reshape(B, S, D)


def setup_inputs(seed: int = 0) -> dict:
    key = jax.random.key(seed)
    ks = jax.random.split(key, 24)
    n_ml = (DEPTH + 1) // N_MIXERS
    n_sw = DEPTH // N_MIXERS
    D = D_MODEL
    nrm = lambda k, shape, s: jax.random.normal(k, shape, jnp.float32) * s
    b_i = -1.0 + nrm(ks[6], (n_ml, ML_HEADS), 0.1)
    b_f = 3.0 + nrm(ks[7], (n_ml, ML_HEADS), 0.5)
    return {
        "x": nrm(ks[0], (BATCH, SEQ, D), 1.0),
        "c": nrm(ks[1], (BATCH, D), 1.0),
        "w_ada": nrm(ks[2], (DEPTH, D, 6 * D), 0.5 * D ** -0.5),
        "b_ada": nrm(ks[3], (DEPTH, 6 * D), 0.02),
        "norm1_g": 1.0 + nrm(ks[4], (DEPTH, D), 0.05),
        "norm2_g": 1.0 + nrm(ks[5], (DEPTH, D), 0.05),
        "ml_w_in": nrm(ks[8], (n_ml, D, ML_IN), D ** -0.5),
        "ml_b_gate": jnp.concatenate([b_i, b_f], axis=-1),
        "ml_g_out": 1.0 + nrm(ks[9], (n_ml, ML_V), 0.05),
        "ml_w_out": nrm(ks[10], (n_ml, ML_V, D), ML_V ** -0.5),
        "sw_w_in": nrm(ks[11], (n_sw, D, SW_IN), D ** -0.5),
        "sw_g_q": 1.0 + nrm(ks[12], (n_sw, SW_HEAD_DIM), 0.05),
        "sw_g_k": 1.0 + nrm(ks[13], (n_sw, SW_HEAD_DIM), 0.05),
        "sw_sinks": nrm(ks[14], (n_sw, SW_Q_HEADS), 0.5),
        "sw_w_out": nrm(ks[15], (n_sw, SW_OUT_IN, D), SW_OUT_IN ** -0.5),
        "moe_w_group": nrm(ks[16], (DEPTH, D, N_GROUPS), D ** -0.5),
        "moe_b_group": nrm(ks[17], (DEPTH, N_GROUPS), 0.01),
        "moe_w_router": nrm(ks[18], (DEPTH, D, N_EXPERTS), D ** -0.5),
        "moe_b_router": nrm(ks[19], (DEPTH, N_EXPERTS), 0.01),
        "moe_w1": nrm(ks[20], (DEPTH, N_EXPERTS, D, D_EXPERT), D ** -0.5),
        "moe_w3": nrm(ks[21], (DEPTH, N_EXPERTS, D, D_EXPERT), D ** -0.5),
        "moe_w2": nrm(ks[22], (DEPTH, N_EXPERTS, D_EXPERT, D), D_EXPERT ** -0.5),
    }


def reference(x, c, w_ada, b_ada, norm1_g, norm2_g, ml_w_in, ml_b_gate, ml_g_out, ml_w_out,
              sw_w_in, sw_g_q, sw_g_k, sw_sinks, sw_w_out, moe_w_group, moe_b_group,
              moe_w_router, moe_b_router, moe_w1, moe_w3, moe_w2):
    cond = jax.nn.silu(c)
    for layer in range(DEPTH):
        mod = (cond @ w_ada[layer] + b_ada[layer])[:, None, :]
        sh1, sc1, gt1, sh2, sc2, gt2 = jnp.split(mod, 6, axis=-1)
        hn = rmsnorm(x, norm1_g[layer]) * (1.0 + sc1) + sh1
        j = layer // N_MIXERS
        if layer % N_MIXERS == 0:
            y = mlstm_mixer(hn, ml_w_in[j], ml_b_gate[j], ml_g_out[j], ml_w_out[j])
        else:
            y = swa_mixer(hn, sw_w_in[j], sw_g_q[j], sw_g_k[j], sw_sinks[j], sw_w_out[j])
        x = x + gt1 * y
        hn = rmsnorm(x, norm2_g[layer]) * (1.0 + sc2) + sh2
        x = x + gt2 * hier_moe(hn, moe_w_group[layer], moe_b_group[layer], moe_w_router[layer],
                               moe_b_router[layer], moe_w1[layer], moe_w3[layer], moe_w2[layer])
    return x
```

```cpp
#include <hip/hip_runtime.h>
#include <cstdio>
#include <cstdint>

#define GAS __attribute__((address_space(1)))
#define LAS __attribute__((address_space(3)))
typedef unsigned short bf16_t;
typedef short bf16x8 __attribute__((ext_vector_type(8)));
typedef float f32x4 __attribute__((ext_vector_type(4)));
typedef int i32x4 __attribute__((ext_vector_type(4)));
typedef float f32x2 __attribute__((ext_vector_type(2)));
typedef unsigned u32x4 __attribute__((ext_vector_type(4)));
typedef unsigned u32x2 __attribute__((ext_vector_type(2)));
typedef GAS float gfloat; typedef GAS bf16_t gbf16; typedef GAS unsigned gu32; typedef GAS unsigned char gu8;

#ifndef MK_PER_PHASE
#define MK_PER_PHASE 0
#endif

constexpr int NBATCH = 4, SEQ = 8192, D = 1024, T = NBATCH * SEQ, DEPTH = 4;
constexpr int ML_H = 4, ML_DK = 128, ML_DV = 256, ML_N = 3072, ML_IN = 3080;
constexpr int LC = 128, NCH = SEQ / LC, ML_UNITS = NBATCH * ML_H * NCH;
constexpr int ST_ROWS = ML_DV + 1, ST_ELEMS = ST_ROWS * ML_DK;
constexpr int SW_QH = 16, SW_KVH = 4, SW_DH = 64, SW_N = 1536, WIN = 128;
constexpr int NE = 64, DE = 384, NRT = 80;
constexpr int CAP = 32768, MAXBLK = 320;
constexpr float EPS = 1e-6f, GATE_CAP = 15.0f;

constexpr size_t MiB = 1u << 20;
constexpr size_t WS_CTL = 0, CTL_ZERO_BYTES = 128 * 1024;
constexpr size_t WS_MOD = 1 * MiB;
constexpr size_t WS_MODP = 2 * MiB;
constexpr size_t WS_WRT = 8 * MiB;
constexpr size_t WS_WMLG = 9 * MiB;
constexpr size_t WS_IG = 10 * MiB, WS_LF = 11 * MiB;
constexpr size_t WS_CS = 12 * MiB;
constexpr size_t WS_TOKINFO = 13 * MiB, WS_TOKGATE = 14 * MiB;
constexpr size_t WS_WMLIN = 16 * MiB;
constexpr size_t WS_WMLOUT = 28 * MiB;
constexpr size_t WS_WSWIN = 32 * MiB;
constexpr size_t WS_WSWOUT = 38 * MiB;
constexpr size_t WS_LIST = 42 * MiB;
constexpr size_t WS_HN = 64 * MiB;
constexpr size_t WS_UST = 128 * MiB;
constexpr size_t WS_CST = 194 * MiB;
constexpr size_t WS_BIG = 260 * MiB;
constexpr size_t WS_PROJ = WS_BIG, WS_MIX = WS_BIG + 192 * MiB, WS_YS = WS_BIG, WS_H1 = WS_BIG + 160 * MiB;
constexpr size_t WS_W13 = 516 * MiB;
constexpr size_t WS_W2 = 900 * MiB;
constexpr size_t WS_XB = 1092 * MiB;
constexpr size_t WS_SA = 15 * MiB;
constexpr size_t WS_SBIN = 15 * MiB + 256 * 1024;
constexpr size_t WS_SAM = 15 * MiB + 512 * 1024;
constexpr size_t WS_SBOUT = 15 * MiB + 768 * 1024;
constexpr size_t WS_MIXQ = 64 * MiB;
constexpr size_t WS_YSS = WS_BIG + 96 * MiB;
constexpr size_t WS_SAE = 50 * MiB;
constexpr size_t WS_SB13 = 58 * MiB;
constexpr size_t WS_HNQ = WS_BIG + 220 * MiB;
constexpr size_t WS_END = 1156 * MiB;
constexpr int CW_TMO = 0, CW_BAR = 4096, CW_CNT = 16384;

constexpr int RING_BYTES = 131072;
constexpr int TAB_OFF = 141312;
constexpr int TAB_BLK2E = TAB_OFF, TAB_BLKSTART = TAB_OFF + 1280, TAB_CNT = TAB_OFF + 1600, TAB_NBLK = TAB_OFF + 1856, TAB_XBLK = TAB_OFF + 2048;
constexpr int MISC_OFF = TAB_OFF + 4096;
constexpr int LDS_BYTES = 147456;
constexpr int NWAVES = 8, NTHREADS = 512;

__device__ __forceinline__ float bf2f(unsigned h) { return __uint_as_float(h << 16); }
__device__ __forceinline__ unsigned f2bf(float f) { unsigned u = __float_as_uint(f); return (u + 0x7fffu + ((u >> 16) & 1u)) >> 16; }
typedef __bf16 bf16x2_t __attribute__((ext_vector_type(2)));
__device__ __forceinline__ unsigned pk2(float lo, float hi) { const f32x2 v = {lo, hi}; return __builtin_bit_cast(unsigned, __builtin_convertvector(v, bf16x2_t)); }
__device__ __forceinline__ unsigned pkq4(float x0, float x1, float x2, float x3) {
    const unsigned u0 = __float_as_uint(x0 + 12582912.f), u1 = __float_as_uint(x1 + 12582912.f), u2 = __float_as_uint(x2 + 12582912.f), u3 = __float_as_uint(x3 + 12582912.f);
    const unsigned t01 = __builtin_amdgcn_perm(u1, u0, 0x0c0c0400u), t23 = __builtin_amdgcn_perm(u3, u2, 0x0c0c0400u);
    return t01 | (t23 << 16);
}
__device__ __forceinline__ f32x4 unq4(unsigned w, float sc) {
    const int iw = (int)w;
    return (f32x4){(float)((iw << 24) >> 24), (float)((iw << 16) >> 24), (float)((iw << 8) >> 24), (float)(iw >> 24)} * sc;
}
__device__ __forceinline__ void st16_wt(GAS void* p, u32x4 v) { asm volatile("global_store_dwordx4 %0, %1, off sc1\n\ts_nop 1" :: "v"(p), "v"(v) : "memory"); }
__device__ __forceinline__ float shfl_xor_l(float v, int o, int lane) { return __int_as_float(__builtin_amdgcn_ds_bpermute((lane ^ o) << 2, __float_as_int(v))); }
__device__ __forceinline__ float wave_sum(float v, int lane) {
#pragma unroll
    for (int o = 1; o < 64; o <<= 1) v += shfl_xor_l(v, o, lane);
    return v;
}
__device__ __forceinline__ float frcp(float x) { return __builtin_amdgcn_rcpf(x); }
__device__ __forceinline__ float sigmoidf_(float x) { return frcp(1.f + __expf(-x)); }
__device__ __forceinline__ void unpack8(u32x4 w, float (&o)[8]) {
    o[0] = bf2f(w.x & 0xffffu); o[1] = bf2f(w.x >> 16); o[2] = bf2f(w.y & 0xffffu); o[3] = bf2f(w.y >> 16);
    o[4] = bf2f(w.z & 0xffffu); o[5] = bf2f(w.z >> 16); o[6] = bf2f(w.w & 0xffffu); o[7] = bf2f(w.w >> 16);
}

__device__ __forceinline__ int lane_id_asm() { int ln; asm volatile("v_mbcnt_lo_u32_b32 %0, -1, 0\n\tv_mbcnt_hi_u32_b32 %0, -1, %0" : "=v"(ln)); return ln; }
namespace pg8 {
constexpr int BM = 256, BK = 64, HALF = 128, HTB = HALF * BK * 2, STAGE_BYTES = 8 * HTB, NXCD = 8, WGM = 8;
constexpr int SCL_REL = STAGE_BYTES;
__host__ __device__ __forceinline__ int lds_byte(int r, int c) { const int st = (r >> 4) * 2 + (c >> 5), rr = r & 15, cc = c & 31, ob = rr * 64 + cc * 2; return st * 1024 + (ob ^ (((ob >> 9) & 1) << 5)); }
__host__ __device__ __forceinline__ void stage_rc(int b, int& R, int& C) { const int st = b / 1024, sb = b % 1024, swz = sb ^ (((sb >> 9) & 1) << 5); R = (st >> 1) * 16 + swz / 64; C = (st & 1) * 32 + (swz % 64) / 2; }
__host__ __device__ __forceinline__ int perm32(int rho) { const int n = rho >> 4, i = rho & 15; return 8 * (i >> 2) + 4 * n + (i & 3); }
__device__ __forceinline__ unsigned cvt_pk_bf16(float lo, float hi) { unsigned r; asm volatile("v_cvt_pk_bf16_f32 %0, %1, %2" : "=v"(r) : "v"(lo), "v"(hi)); return r; }

struct Unit { int pm, pn, pb; };

struct DenseOrder {
    static constexpr bool GATHER = false;
    int nM, nN, nwg, G, c;
    __device__ void init(int M, int N, int G_, int c_) { nM = M / BM; nN = N / BM; nwg = nM * nN; G = G_; c = c_; }
    __device__ __forceinline__ bool next(int i, Unit& u) const {
        const long L = (long)i * G + c; if (L >= nwg) return false;
        int wgid = (int)L; { const int q = nwg / NXCD, r = nwg % NXCD, xcd = wgid % NXCD, off = wgid / NXCD; wgid = (xcd < r ? xcd * (q + 1) : r * (q + 1) + (xcd - r) * q) + off; }
        const int nig = WGM * nN, gid = wgid / nig, fm = gid * WGM, gsz = (nM - fm) < WGM ? (nM - fm) : WGM;
        u.pm = fm + ((wgid % nig) % gsz); u.pn = (wgid % nig) / gsz; u.pb = u.pn; return true;
    }
    __device__ __forceinline__ unsigned a_row(const Unit& u, int h, int R) const { return (unsigned)(u.pm * BM + h * HALF + R); }
};
template <int NT, bool GATHER_> struct MoeOrder {
    static constexpr bool GATHER = GATHER_;
    const LAS int* blk2e; const LAS int* blkstart; const LAS int* cnt; const LAS int* xblk; const gu32* list; int nunits, W, r;
    __device__ __forceinline__ bool next(int i, Unit& u) const {
        const int L = i * W + r; if (L >= nunits) return false;
        const int bi = L / NT, nt = L - bi * NT, blk = xblk[bi], e = blk2e[blk];
        u.pm = blk; u.pn = nt; u.pb = e * NT + nt; return true;
    }
    __device__ __forceinline__ unsigned a_row(const Unit& u, int h, int R) const {
        if (!GATHER_) return (unsigned)(u.pm * BM + h * HALF + R);
        const int e = blk2e[u.pm]; const int rank = (u.pm - blkstart[e]) * BM + h * HALF + R;
        return rank < cnt[e] ? list[(size_t)e * CAP + rank] : 0u;
    }
};

struct EpiBf16 {
    static constexpr bool PERM = true; static constexpr int NSTORES = 16;
    gbf16* O; int ldc; int ks_lo, ks_hi; float kscale;
    __device__ __forceinline__ void operator()(const f32x4 (&acc)[2][2][4][2], const Unit& u, int wr, int wc, int fr, int fq) const {
        const float sc = (u.pn >= ks_lo && u.pn < ks_hi) ? kscale : 1.f;
        const int row0 = u.pm * BM + wr * 64 + fr, col0 = u.pn * BM + wc * 32 + 8 * fq;
#pragma unroll
        for (int ai = 0; ai < 2; ++ai)
#pragma unroll
            for (int m = 0; m < 4; ++m) { gbf16* rowp = O + (size_t)(row0 + ai * HALF + m * 16) * ldc + col0;
#pragma unroll
                for (int bj = 0; bj < 2; ++bj) { const f32x4 v0 = acc[ai][bj][m][0] * sc, v1 = acc[ai][bj][m][1] * sc;
                    u32x4 w; w.x = cvt_pk_bf16(v0[0], v0[1]); w.y = cvt_pk_bf16(v0[2], v0[3]); w.z = cvt_pk_bf16(v1[0], v1[1]); w.w = cvt_pk_bf16(v1[2], v1[3]);
                    *(GAS u32x4*)(rowp + bj * HALF) = w; } }
    }
};
struct EpiBf16Q {
    static constexpr bool PERM = true; static constexpr int NSTORES = 16;
    gbf16* O; int ldc; int ks_lo, ks_hi; float kscale; const gfloat* sa; const gfloat* sb;
    __device__ __forceinline__ void pre(const Unit& u, int wid, LAS float* buf) const {
        const int ln = lane_id_asm();
        const gfloat* src = (wid < 4) ? sa + (size_t)u.pm * BM + 64 * wid + ln : sb + (size_t)u.pn * BM + 64 * (wid - 4) + ln;
        __builtin_amdgcn_global_load_lds((const GAS unsigned*)src, (LAS unsigned*)(buf + 64 * wid), 4, 0, 0);
    }
    __device__ __forceinline__ void operator()(const f32x4 (&acc)[2][2][4][2], const Unit& u, int wr, int wc, int fr, int fq, const LAS float* buf) const {
        const float sc = (u.pn >= ks_lo && u.pn < ks_hi) ? kscale : 1.f;
        const int row0 = u.pm * BM + wr * 64 + fr, col0 = u.pn * BM + wc * 32 + 8 * fq;
        f32x4 sbv[2][2]; float sav[2][4];
#pragma unroll
        for (int bj = 0; bj < 2; ++bj)
#pragma unroll
            for (int n = 0; n < 2; ++n) sbv[bj][n] = *(const LAS f32x4*)(buf + 256 + wc * 32 + 8 * fq + bj * HALF + 4 * n);
#pragma unroll
        for (int ai = 0; ai < 2; ++ai)
#pragma unroll
            for (int m = 0; m < 4; ++m) sav[ai][m] = buf[wr * 64 + fr + ai * HALF + m * 16];
#pragma unroll
        for (int ai = 0; ai < 2; ++ai)
#pragma unroll
            for (int m = 0; m < 4; ++m) { gbf16* rowp = O + (size_t)(row0 + ai * HALF + m * 16) * ldc + col0; const float rs = sav[ai][m] * sc;
#pragma unroll
                for (int bj = 0; bj < 2; ++bj) {
                    const f32x4 v0 = __builtin_convertvector(__builtin_bit_cast(i32x4, acc[ai][bj][m][0]), f32x4) * sbv[bj][0] * rs;
                    const f32x4 v1 = __builtin_convertvector(__builtin_bit_cast(i32x4, acc[ai][bj][m][1]), f32x4) * sbv[bj][1] * rs;
                    u32x4 w; w.x = cvt_pk_bf16(v0[0], v0[1]); w.y = cvt_pk_bf16(v0[2], v0[3]); w.z = cvt_pk_bf16(v1[0], v1[1]); w.w = cvt_pk_bf16(v1[2], v1[3]);
                    st16_wt(rowp + bj * HALF, w); } }
    }
};
struct EpiYsQ {
    static constexpr bool PERM = true; static constexpr int NSTORES = 16;
    gu8* Y; gfloat* YSc;
    __device__ __forceinline__ void operator()(const f32x4 (&acc)[2][2][4][2], const Unit& u, int wr, int wc, int fr, int fq) const {
        const int lane = fr + 16 * fq;
        const int row0 = u.pm * BM + wr * 64 + fr, colw = u.pn * BM + wc * 32;
        float mx[2][4][2];
#pragma unroll
        for (int ai = 0; ai < 2; ++ai)
#pragma unroll
            for (int m = 0; m < 4; ++m)
#pragma unroll
                for (int bj = 0; bj < 2; ++bj) { const f32x4 a = acc[ai][bj][m][0], b = acc[ai][bj][m][1];
                    mx[ai][m][bj] = fmaxf(fmaxf(fmaxf(fabsf(a[0]), fabsf(a[1])), fmaxf(fabsf(a[2]), fabsf(a[3]))), fmaxf(fmaxf(fabsf(b[0]), fabsf(b[1])), fmaxf(fabsf(b[2]), fabsf(b[3])))); }
#pragma unroll
        for (int o = 16; o < 64; o <<= 1)
#pragma unroll
            for (int ai = 0; ai < 2; ++ai)
#pragma unroll
                for (int m = 0; m < 4; ++m)
#pragma unroll
                    for (int bj = 0; bj < 2; ++bj) mx[ai][m][bj] = fmaxf(mx[ai][m][bj], shfl_xor_l(mx[ai][m][bj], o, lane));
#pragma unroll
        for (int ai = 0; ai < 2; ++ai)
#pragma unroll
            for (int m = 0; m < 4; ++m) { const size_t row = (size_t)(row0 + ai * HALF + m * 16);
#pragma unroll
                for (int bj = 0; bj < 2; ++bj) { const float m_ = fmaxf(mx[ai][m][bj], 1e-30f), inv = 127.f * __builtin_amdgcn_rcpf(m_);
                    const f32x4 a = acc[ai][bj][m][0] * inv, b = acc[ai][bj][m][1] * inv;
                    u32x2 q; q.x = pkq4(a[0], a[1], a[2], a[3]); q.y = pkq4(b[0], b[1], b[2], b[3]);
                    *(GAS u32x2*)(Y + row * D + colw + bj * HALF + 8 * fq) = q;
                    if (fq == 0) YSc[row * 32 + ((colw + bj * HALF) >> 5)] = m_ * (1.f / 127.f); } }
    }
};
struct EpiResid {
    static constexpr bool PERM = true; static constexpr int NSTORES = 16;
    gbf16* X; const gfloat* gate; int gate_bstride;
    __device__ __forceinline__ void operator()(const f32x4 (&acc)[2][2][4][2], const Unit& u, int wr, int wc, int fr, int fq) const {
        const int b = (u.pm * BM) / SEQ; const gfloat* gp = gate + (size_t)b * gate_bstride;
        const int row0 = u.pm * BM + wr * 64 + fr, col0 = u.pn * BM + wc * 32 + 8 * fq;
        f32x4 gv[2][2];
#pragma unroll
        for (int bj = 0; bj < 2; ++bj)
#pragma unroll
            for (int n = 0; n < 2; ++n) gv[bj][n] = *(const GAS f32x4*)(gp + col0 + bj * HALF + 4 * n);
#pragma unroll
        for (int ai = 0; ai < 2; ++ai) {
            u32x4 xr[4][2];
#pragma unroll
            for (int m = 0; m < 4; ++m)
#pragma unroll
                for (int bj = 0; bj < 2; ++bj) xr[m][bj] = *(const GAS u32x4*)(X + (size_t)(row0 + ai * HALF + m * 16) * D + col0 + bj * HALF);
            asm volatile("" ::: "memory");
#pragma unroll
            for (int m = 0; m < 4; ++m)
#pragma unroll
                for (int bj = 0; bj < 2; ++bj) { float x[8]; unpack8(xr[m][bj], x);
                    const f32x4 v0 = acc[ai][bj][m][0] * gv[bj][0], v1 = acc[ai][bj][m][1] * gv[bj][1];
                    u32x4 w; w.x = cvt_pk_bf16(x[0] + v0[0], x[1] + v0[1]); w.y = cvt_pk_bf16(x[2] + v0[2], x[3] + v0[3]); w.z = cvt_pk_bf16(x[4] + v1[0], x[5] + v1[1]); w.w = cvt_pk_bf16(x[6] + v1[2], x[7] + v1[3]);
                    *(GAS u32x4*)(X + (size_t)(row0 + ai * HALF + m * 16) * D + col0 + bj * HALF) = w; }
        }
    }
};
struct EpiResidQ {
    static constexpr bool PERM = true; static constexpr int NSTORES = 16;
    gbf16* X; const gfloat* gate; int gate_bstride; const gfloat* sa; const gfloat* sb;
    __device__ __forceinline__ void pre(const Unit& u, int wid, LAS float* buf) const {
        const int ln = lane_id_asm();
        const gfloat* src = (wid < 4) ? sa + (size_t)u.pm * BM + 64 * wid + ln : sb + (size_t)u.pn * BM + 64 * (wid - 4) + ln;
        __builtin_amdgcn_global_load_lds((const GAS unsigned*)src, (LAS unsigned*)(buf + 64 * wid), 4, 0, 0);
    }
    __device__ __forceinline__ void operator()(const f32x4 (&acc)[2][2][4][2], const Unit& u, int wr, int wc, int fr, int fq, const LAS float* buf) const {
        const int b = (u.pm * BM) / SEQ; const gfloat* gp = gate + (size_t)b * gate_bstride;
        const int row0 = u.pm * BM + wr * 64 + fr, col0 = u.pn * BM + wc * 32 + 8 * fq;
        f32x4 gv[2][2];
#pragma unroll
        for (int bj = 0; bj < 2; ++bj)
#pragma unroll
            for (int n = 0; n < 2; ++n) gv[bj][n] = *(const GAS f32x4*)(gp + col0 + bj * HALF + 4 * n) * *(const LAS f32x4*)(buf + 256 + wc * 32 + 8 * fq + bj * HALF + 4 * n);
#pragma unroll
        for (int ai = 0; ai < 2; ++ai) {
            u32x4 xr[4][2]; float sav[4];
#pragma unroll
            for (int m = 0; m < 4; ++m)
#pragma unroll
                for (int bj = 0; bj < 2; ++bj) xr[m][bj] = *(const GAS u32x4*)(X + (size_t)(row0 + ai * HALF + m * 16) * D + col0 + bj * HALF);
#pragma unroll
            for (int m = 0; m < 4; ++m) sav[m] = buf[wr * 64 + fr + ai * HALF + m * 16];
            asm volatile("" ::: "memory");
#pragma unroll
            for (int m = 0; m < 4; ++m)
#pragma unroll
                for (int bj = 0; bj < 2; ++bj) { float x[8]; unpack8(xr[m][bj], x);
                    const f32x4 v0 = __builtin_convertvector(__builtin_bit_cast(i32x4, acc[ai][bj][m][0]), f32x4) * gv[bj][0] * sav[m];
                    const f32x4 v1 = __builtin_convertvector(__builtin_bit_cast(i32x4, acc[ai][bj][m][1]), f32x4) * gv[bj][1] * sav[m];
                    u32x4 w; w.x = cvt_pk_bf16(x[0] + v0[0], x[1] + v0[1]); w.y = cvt_pk_bf16(x[2] + v0[2], x[3] + v0[3]); w.z = cvt_pk_bf16(x[4] + v1[0], x[5] + v1[1]); w.w = cvt_pk_bf16(x[6] + v1[2], x[7] + v1[3]);
                    *(GAS u32x4*)(X + (size_t)(row0 + ai * HALF + m * 16) * D + col0 + bj * HALF) = w; }
        }
    }
};
struct EpiSwiglu {
    static constexpr bool PERM = true; static constexpr int NSTORES = 8;
    gbf16* H;
    __device__ __forceinline__ void operator()(const f32x4 (&acc)[2][2][4][2], const Unit& u, int wr, int wc, int fr, int fq) const {
        const int row0 = u.pm * BM + wr * 64 + fr, col0 = u.pn * HALF + wc * 32 + 8 * fq;
#pragma unroll
        for (int ai = 0; ai < 2; ++ai)
#pragma unroll
            for (int m = 0; m < 4; ++m) { gbf16* rowp = H + (size_t)(row0 + ai * HALF + m * 16) * DE + col0;
                float o[8];
#pragma unroll
                for (int n = 0; n < 2; ++n)
#pragma unroll
                    for (int j = 0; j < 4; ++j) { const float a = acc[ai][0][m][n][j], b = acc[ai][1][m][n][j]; o[4 * n + j] = a * __builtin_amdgcn_rcpf(1.f + __expf(-a)) * b; }
                u32x4 w; w.x = cvt_pk_bf16(o[0], o[1]); w.y = cvt_pk_bf16(o[2], o[3]); w.z = cvt_pk_bf16(o[4], o[5]); w.w = cvt_pk_bf16(o[6], o[7]);
                *(GAS u32x4*)rowp = w; }
    }
};

struct EpiSwigluQ {
    static constexpr bool PERM = true; static constexpr int NSTORES = 8;
    gbf16* H; const gfloat* sae; const gfloat* sb; const LAS int* blk2e; const LAS int* blkstart;
    __device__ __forceinline__ void pre(const Unit& u, int wid, LAS float* buf) const {
        const int ln = lane_id_asm();
        const int e = blk2e[u.pm];
        const gfloat* src = (wid < 4) ? sae + (size_t)e * CAP + (u.pm - blkstart[e]) * BM + 64 * wid + ln : sb + (size_t)u.pb * BM + 64 * (wid - 4) + ln;
        __builtin_amdgcn_global_load_lds((const GAS unsigned*)src, (LAS unsigned*)(buf + 64 * wid), 4, 0, 0);
    }
    __device__ __forceinline__ void operator()(const f32x4 (&acc)[2][2][4][2], const Unit& u, int wr, int wc, int fr, int fq, const LAS float* buf) const {
        const int row0 = u.pm * BM + wr * 64 + fr, col0 = u.pn * HALF + wc * 32 + 8 * fq;
        f32x4 sbv[2][2]; float sav[2][4];
#pragma unroll
        for (int bj = 0; bj < 2; ++bj)
#pragma unroll
            for (int n = 0; n < 2; ++n) sbv[bj][n] = *(const LAS f32x4*)(buf + 256 + wc * 32 + 8 * fq + bj * HALF + 4 * n);
#pragma unroll
        for (int ai = 0; ai < 2; ++ai)
#pragma unroll
            for (int m = 0; m < 4; ++m) sav[ai][m] = buf[wr * 64 + fr + ai * HALF + m * 16];
#pragma unroll
        for (int ai = 0; ai < 2; ++ai)
#pragma unroll
            for (int m = 0; m < 4; ++m) { gbf16* rowp = H + (size_t)(row0 + ai * HALF + m * 16) * DE + col0;
                float o[8];
#pragma unroll
                for (int n = 0; n < 2; ++n) {
                    const f32x4 av = __builtin_convertvector(__builtin_bit_cast(i32x4, acc[ai][0][m][n]), f32x4) * sbv[0][n] * sav[ai][m];
                    const f32x4 bv = __builtin_convertvector(__builtin_bit_cast(i32x4, acc[ai][1][m][n]), f32x4) * sbv[1][n] * sav[ai][m];
#pragma unroll
                    for (int j = 0; j < 4; ++j) o[4 * n + j] = av[j] * __builtin_amdgcn_rcpf(1.f + __expf(-av[j])) * bv[j]; }
                u32x4 w; w.x = cvt_pk_bf16(o[0], o[1]); w.y = cvt_pk_bf16(o[2], o[3]); w.z = cvt_pk_bf16(o[4], o[5]); w.w = cvt_pk_bf16(o[6], o[7]);
                *(GAS u32x4*)rowp = w; }
    }
};

template <class Epi, class Sched, bool ALIGN_EPI, bool I8 = false>
__device__ __forceinline__ void gemm_phase(LAS unsigned char* lds, const int tid, const gbf16* A, const gbf16* Bt, int K, const Sched& S, const Epi& E) {
    const int wid = __builtin_amdgcn_readfirstlane(tid >> 6), lane = tid & 63, wr = wid >> 2, wc = wid & 3, fr = lane & 15, fq = lane >> 4;
    const int nt = K / BK;
    int Rr[2], Cc[2]; unsigned voffB[2];
#pragma unroll
    for (int i = 0; i < 2; ++i) { stage_rc(tid * 16 + i * 8192, Rr[i], Cc[i]); const int Rb = Epi::PERM ? ((Rr[i] & ~31) + perm32(Rr[i] & 31)) : Rr[i]; voffB[i] = (unsigned)(Rb * K + Cc[i]) * 2u; }
    const size_t kstep = (size_t)(BK * 2);
    const size_t hstep = (size_t)HALF * K * 2;
    const size_t tstep = 2 * hstep;
    const unsigned ldsw = (unsigned)wid * 1024u;
    const int aoff = lds_byte(wr * 64 + fr, fq * 8), boff = lds_byte(wc * 32 + fr, fq * 8);
#define PG8_SA(b, h) (((b) * 2 + (h)) * HTB)
#define PG8_SB(b, h) ((4 + (b) * 2 + (h)) * HTB)
#define PG8_STAGE(bufoff, gbase, voff) do { _Pragma("unroll") for (int _i = 0; _i < 2; ++_i) \
        __builtin_amdgcn_global_load_lds((const GAS unsigned*)((const GAS char*)(gbase) + (voff)[_i]), (LAS unsigned*)(lds + (bufoff) + ldsw + _i * 8192), 16, 0, 0); } while (0)
#define PG8_LDA(dst, b, h) do { _Pragma("unroll") for (int m = 0; m < 4; ++m) _Pragma("unroll") for (int k = 0; k < 2; ++k) dst[m][k] = *(const LAS bf16x8*)(lds + PG8_SA(b, h) + aoff + m * 2048 + k * 1024); } while (0)
#define PG8_LDB(dst, b, h) do { _Pragma("unroll") for (int n = 0; n < 2; ++n) _Pragma("unroll") for (int k = 0; k < 2; ++k) dst[n][k] = *(const LAS bf16x8*)(lds + PG8_SB(b, h) + boff + n * 2048 + k * 1024); } while (0)
#define PG8_MMA(ai, bj, At, Bt_) do { __builtin_amdgcn_s_setprio(1); _Pragma("unroll") for (int m = 0; m < 4; ++m) _Pragma("unroll") for (int n = 0; n < 2; ++n) _Pragma("unroll") for (int k = 0; k < 2; ++k) \
        { if constexpr (I8) acc[ai][bj][m][n] = __builtin_bit_cast(f32x4, __builtin_amdgcn_mfma_i32_16x16x64_i8(__builtin_bit_cast(i32x4, Bt_[n][k]), __builtin_bit_cast(i32x4, At[m][k]), __builtin_bit_cast(i32x4, acc[ai][bj][m][n]), 0, 0, 0)); \
          else acc[ai][bj][m][n] = __builtin_amdgcn_mfma_f32_16x16x32_bf16(Bt_[n][k], At[m][k], acc[ai][bj][m][n], 0, 0, 0); } __builtin_amdgcn_s_setprio(0); } while (0)
#define PG8_WAIT_V(n) asm volatile("s_waitcnt vmcnt(" #n ")" ::: "memory")
#define PG8_WAIT_RELAX(flag) do { if constexpr (Epi::NSTORES == 16) asm volatile("s_cmp_lg_u32 %0, 0\n\ts_cbranch_scc1 1f\n\ts_waitcnt vmcnt(8)\n\ts_branch 2f\n1:\n\ts_waitcnt vmcnt(24)\n2:" :: "s"(flag) : "memory", "scc"); \
        else { static_assert(Epi::NSTORES == 8 || Epi::NSTORES == 16, "NSTORES"); asm volatile("s_cmp_lg_u32 %0, 0\n\ts_cbranch_scc1 1f\n\ts_waitcnt vmcnt(8)\n\ts_branch 2f\n1:\n\ts_waitcnt vmcnt(16)\n2:" :: "s"(flag) : "memory", "scc"); } } while (0)
#define PG8_WAIT_L(n) asm volatile("s_waitcnt lgkmcnt(" #n ")" ::: "memory")
#define PG8_BAR __builtin_amdgcn_s_barrier()
#define PG8_SCHED __builtin_amdgcn_sched_barrier(0)
    Unit cur, nxt; int ui = 0;
    if (!S.next(0, cur)) return;
    LAS float* const scl = (LAS float*)(lds + SCL_REL);
    f32x4 acc[2][2][4][2];
#pragma unroll
    for (int a = 0; a < 2; ++a)
#pragma unroll
        for (int b = 0; b < 2; ++b)
#pragma unroll
            for (int m = 0; m < 4; ++m)
#pragma unroll
                for (int n = 0; n < 2; ++n) acc[a][b][m][n] = (f32x4){0.f, 0.f, 0.f, 0.f};
    bf16x8 At[4][2], B0[2][2], B1[2][2];
    unsigned vo[2][2], nvo[2][2], voffA[2];
    const GAS char* Ab = (const GAS char*)A;
    const GAS char* cA = Ab; const GAS char* nA = Ab;
    if constexpr (Sched::GATHER) {
#pragma unroll
        for (int h = 0; h < 2; ++h)
#pragma unroll
            for (int i = 0; i < 2; ++i) vo[h][i] = (S.a_row(cur, h, Rr[i]) * (unsigned)K + (unsigned)Cc[i]) * 2u;
    } else {
#pragma unroll
        for (int i = 0; i < 2; ++i) voffA[i] = (unsigned)(Rr[i] * K + Cc[i]) * 2u;
        cA = Ab + (size_t)cur.pm * tstep;
    }
#define PG8_STAGE_A(bufoff, kb, h, NEXT) do { if constexpr (Sched::GATHER) { const unsigned _vv[2] = {(NEXT) ? nvo[h][0] : vo[h][0], (NEXT) ? nvo[h][1] : vo[h][1]}; PG8_STAGE(bufoff, Ab + (kb), _vv); } \
        else { PG8_STAGE(bufoff, ((NEXT) ? nA : cA) + (size_t)(h) * hstep + (kb), voffA); } } while (0)
    const GAS char* cB = (const GAS char*)Bt + (size_t)cur.pb * tstep;
    PG8_STAGE(PG8_SB(0, 0), cB, voffB); PG8_STAGE(PG8_SB(0, 1), cB + hstep, voffB); PG8_STAGE_A(PG8_SA(0, 0), (size_t)0, 0, false); PG8_STAGE_A(PG8_SA(0, 1), (size_t)0, 1, false);
    if (wr == 1) PG8_BAR;
    PG8_WAIT_V(2); PG8_BAR;
    PG8_STAGE(PG8_SB(1, 0), cB + kstep, voffB); PG8_STAGE_A(PG8_SA(1, 0), kstep, 0, false); PG8_STAGE(PG8_SB(1, 1), cB + hstep + kstep, voffB);
    PG8_WAIT_V(6); PG8_BAR;
    for (;;) {
        const bool has_next = S.next(ui + 1, nxt);
        if constexpr (Sched::GATHER) {
#pragma unroll
            for (int h = 0; h < 2; ++h)
#pragma unroll
                for (int i = 0; i < 2; ++i) nvo[h][i] = has_next ? (S.a_row(nxt, h, Rr[i]) * (unsigned)K + (unsigned)Cc[i]) * 2u : vo[h][i];
        } else nA = has_next ? Ab + (size_t)nxt.pm * tstep : cA;
        const GAS char* nB = has_next ? (const GAS char*)Bt + (size_t)nxt.pb * tstep : cB;
        if constexpr (I8) E.pre(cur, wid, scl + (ui & 1) * 512);
        for (int t = 0; t < nt; t += 2) {
            const bool last = (t == nt - 2);
            const size_t k1 = (size_t)(t + 1) * kstep, k2 = last ? (size_t)0 : (size_t)(t + 2) * kstep, k3 = k2 + kstep;
            const GAS char* b2 = last ? nB : cB + (size_t)(t + 2) * kstep; const GAS char* b3 = b2 + kstep;
            const int relax = __builtin_amdgcn_readfirstlane(((ui > 0) && (t == 0)) ? 1 : 0);
            PG8_LDB(B0, 0, 0); PG8_LDB(B1, 0, 1); PG8_SCHED; PG8_LDA(At, 0, 0); PG8_STAGE_A(PG8_SA(1, 1), k1, 1, false);
            PG8_WAIT_RELAX(relax);
            PG8_WAIT_L(0); PG8_BAR; PG8_MMA(0, 0, At, B0); PG8_MMA(0, 1, At, B1); PG8_BAR; PG8_SCHED;
            PG8_LDA(At, 0, 1); PG8_STAGE(PG8_SB(0, 0), b2, voffB); PG8_STAGE(PG8_SB(0, 1), b2 + hstep, voffB); PG8_STAGE_A(PG8_SA(0, 0), k2, 0, last);
            PG8_WAIT_RELAX(relax);
            PG8_WAIT_L(0); PG8_BAR; PG8_MMA(1, 0, At, B0); PG8_MMA(1, 1, At, B1); PG8_BAR; PG8_SCHED;
            PG8_LDB(B0, 1, 0); PG8_LDB(B1, 1, 1); PG8_SCHED; PG8_LDA(At, 1, 0); PG8_STAGE_A(PG8_SA(0, 1), k2, 1, last);
            PG8_WAIT_V(8); PG8_WAIT_L(0); PG8_BAR; PG8_MMA(0, 0, At, B0); PG8_MMA(0, 1, At, B1); PG8_BAR; PG8_SCHED;
            PG8_LDA(At, 1, 1); PG8_STAGE(PG8_SB(1, 0), b3, voffB); PG8_STAGE(PG8_SB(1, 1), b3 + hstep, voffB); PG8_STAGE_A(PG8_SA(1, 0), k3, 0, last);
            PG8_WAIT_V(8); PG8_WAIT_L(0); PG8_BAR; PG8_MMA(1, 0, At, B0); PG8_MMA(1, 1, At, B1); PG8_BAR; PG8_SCHED;
        }
        if constexpr (ALIGN_EPI) { if (wr == 0) PG8_BAR; }
        { const int le = lane_id_asm(); if constexpr (I8) E(acc, cur, wr, wc, le & 15, le >> 4, scl + (ui & 1) * 512); else E(acc, cur, wr, wc, le & 15, le >> 4); }
        if (!has_next) break;
#pragma unroll
        for (int a = 0; a < 2; ++a)
#pragma unroll
            for (int b = 0; b < 2; ++b)
#pragma unroll
                for (int m = 0; m < 4; ++m)
#pragma unroll
                    for (int n = 0; n < 2; ++n) acc[a][b][m][n] = (f32x4){0.f, 0.f, 0.f, 0.f};
        cur = nxt; cB = nB; ++ui;
        if constexpr (Sched::GATHER) {
#pragma unroll
            for (int h = 0; h < 2; ++h)
#pragma unroll
                for (int i = 0; i < 2; ++i) vo[h][i] = nvo[h][i];
        } else cA = nA;
        if constexpr (ALIGN_EPI) { if (wr == 1) PG8_BAR; }
    }
    PG8_WAIT_V(0);
    if constexpr (!ALIGN_EPI) { if (wr == 0) PG8_BAR; }
    PG8_BAR;
#undef PG8_SA
#undef PG8_SB
#undef PG8_STAGE
#undef PG8_STAGE_A
#undef PG8_LDA
#undef PG8_LDB
#undef PG8_MMA
#undef PG8_WAIT_V
#undef PG8_WAIT_L
#undef PG8_WAIT_RELAX
#undef PG8_BAR
#undef PG8_SCHED
}
}

#define XB_TMO      128
#define XB_XCNT(j)  (256  + 64 * (j))
#define XB_XSUB(j)  (1280 + 64 * (j))
#define XB_XGEN(j)  (2304 + 64 * (j))
#define XB_TOP      3328
#define XB_TOPGEN   3392
#define XCD_BAR_WORDS 3456
#define XB_SPIN_CAP (1u << 18)
__device__ __forceinline__ unsigned xb_ld(gu32* p)              { return __hip_atomic_load(p, __ATOMIC_RELAXED, __HIP_MEMORY_SCOPE_AGENT); }
__device__ __forceinline__ unsigned xb_add(gu32* p, unsigned v) { return __hip_atomic_fetch_add(p, v, __ATOMIC_RELAXED, __HIP_MEMORY_SCOPE_AGENT); }
__device__ __forceinline__ unsigned xb_xcc_id() { return (unsigned)__builtin_amdgcn_s_getreg((3 << 11) | 20) & 0xFu; }
#define XB_SPIN(cond, bar) do { unsigned _sp = 0; while (cond) { __builtin_amdgcn_s_sleep(1); \
    if ((++_sp & 255u) == 0u) { if (xb_ld(&(bar)[XB_TMO])) break; if (_sp > XB_SPIN_CAP) { (void)xb_add(&(bar)[XB_TMO], 1u); break; } } } } while (0)
struct XcdBarrier { gu32* bar; unsigned x; volatile LAS unsigned* st; };
__device__ __forceinline__ XcdBarrier xcd_barrier_post(gu32* bar, volatile LAS unsigned* st, bool leader) {
    XcdBarrier b; b.bar = bar; b.x = xb_xcc_id(); b.st = st;
    if (leader) (void)xb_add(&bar[XB_XCNT(b.x)], 1u);
    return b;
}
__device__ __forceinline__ void xcd_barrier_complete(gu32* bar, unsigned x, unsigned& nloc, unsigned& nx) {
    const unsigned G = gridDim.x * gridDim.y * gridDim.z;
    unsigned sum, cnt, mine, sp = 0u;
    for (;;) {
        sum = 0u; cnt = 0u; mine = 0u;
#pragma unroll
        for (unsigned j = 0; j < 16; ++j) { const unsigned c = xb_ld(&bar[XB_XCNT(j)]); sum += c; cnt += (c > 0u) ? 1u : 0u; mine = (j == x) ? c : mine; }
        if (sum == G) break;
        __builtin_amdgcn_s_sleep(1);
        if ((++sp & 255u) == 0u) { if (xb_ld(&bar[XB_TMO])) break; if (sp > XB_SPIN_CAP) { (void)xb_add(&bar[XB_TMO], 1u); break; } }
    }
    nloc = mine > 0u ? mine : 1u; nx = cnt > 0u ? cnt : 1u;
}
__device__ __forceinline__ void xcd_barrier(const XcdBarrier& b, bool leader) {
    asm volatile("s_waitcnt vmcnt(0)" ::: "memory");
    __syncthreads();
    if (leader) {
        gu32* bar = b.bar; asm volatile("" : "+s"(bar));
        __builtin_amdgcn_s_waitcnt(0);
        unsigned nloc = b.st[0], nx = b.st[1];
        if (nloc == 0u) { xcd_barrier_complete(bar, b.x, nloc, nx); b.st[0] = nloc; b.st[1] = nx; }
        const unsigned old = xb_add(&bar[XB_XSUB(b.x)], 1u);
        const unsigned gen = old / nloc;
        if (old + 1u == (gen + 1u) * nloc) {
            __builtin_amdgcn_fence(__ATOMIC_RELEASE, "agent");
            asm volatile("s_waitcnt vmcnt(0)" ::: "memory");
            const unsigned og = xb_add(&bar[XB_TOP], 1u);
            const unsigned tg = og / nx;
            if (og + 1u == (tg + 1u) * nx) xb_add(&bar[XB_TOPGEN], 1u);
            else XB_SPIN(xb_ld(&bar[XB_TOPGEN]) == tg, bar);
            __builtin_amdgcn_fence(__ATOMIC_ACQUIRE, "agent");
            xb_add(&bar[XB_XGEN(b.x)], 1u);
            asm volatile("s_waitcnt vmcnt(0)" ::: "memory");
        } else {
            XB_SPIN(xb_ld(&bar[XB_XGEN(b.x)]) == gen, bar);
            __builtin_amdgcn_fence(__ATOMIC_ACQUIRE, "agent");
            asm volatile("s_waitcnt vmcnt(0)" ::: "memory");
        }
    }
    __syncthreads();
}

struct Args { const float* in[22]; float* out; unsigned char* ws; int ph_lo, ph_hi; };
typedef const Args __attribute__((address_space(4)))* ArgsP;
struct Frame {
    unsigned char* sm;
    LAS unsigned char* lds;
    gu32* ctl;
    gu8* ws;
    int tid, lane, wave, G, bid;
    ArgsP ap;
    gfloat* out;
};
#define WSP(T_, off) ((GAS T_*)(F.ws + (off)))
#define FIN(i) ((const gfloat*)F.ap->in[i])
__device__ __forceinline__ void frame_init(Frame& F, unsigned char* lds, int wave0) {
    int ln; asm volatile("v_mbcnt_lo_u32_b32 %0, -1, 0\n\tv_mbcnt_hi_u32_b32 %0, -1, %0" : "=v"(ln));
    int wv = wave0; asm volatile("" : "+s"(wv));
    F.lane = ln; F.wave = wv; F.tid = wv * 64 + ln;
    int bid = blockIdx.x; asm volatile("" : "+s"(bid)); F.bid = bid; F.G = gridDim.x;
    ArgsP ap = (ArgsP)__builtin_amdgcn_kernarg_segment_ptr(); asm volatile("" : "+s"(ap)); F.ap = ap;
    gu8* ws = (gu8*)ap->ws; asm volatile("" : "+s"(ws)); F.ws = ws; F.ctl = (gu32*)(ws + WS_CTL);
    gfloat* out = (gfloat*)ap->out; asm volatile("" : "+s"(out)); F.out = out;
    F.sm = lds; F.lds = (LAS unsigned char*)lds;
}

__device__ __forceinline__ void transpose_item(const gfloat* W, int ldw, int k0, int n0, gbf16* WT, int K, size_t row_base, float* scr, int lane) {
#pragma unroll 8
    for (int i = 0; i < 32; ++i) { const int kk = 2 * i + (lane >> 5); scr[kk * 33 + (lane & 31)] = W[(size_t)(k0 + kk) * ldw + n0 + (lane & 31)]; }
    asm volatile("s_waitcnt lgkmcnt(0)" ::: "memory");
    const int c = lane & 7;
#pragma unroll
    for (int j = 0; j < 4; ++j) { const int n = (lane >> 3) + 8 * j; const float* s = scr + (8 * c) * 33 + n;
        u32x4 o; o.x = pk2(s[0 * 33], s[1 * 33]); o.y = pk2(s[2 * 33], s[3 * 33]); o.z = pk2(s[4 * 33], s[5 * 33]); o.w = pk2(s[6 * 33], s[7 * 33]);
        *(GAS u32x4*)(WT + (row_base + n) * (size_t)K + k0 + 8 * c) = o; }
    asm volatile("s_waitcnt lgkmcnt(0)" ::: "memory");
}
__device__ __forceinline__ bool dense_items(int& r, const gfloat* W, int K, int N, int ldw, gbf16* WT, float* scr, int lane) {
    const int nb = N / 32, items = (K / 64) * nb;
    if (r >= items) { r -= items; return false; }
    const int kb = r / nb, n0 = 32 * (r % nb);
    transpose_item(W, ldw, 64 * kb, n0, WT, K, (size_t)n0, scr, lane);
    return true;
}

__device__ __forceinline__ void quant_item_wg(Frame& F, const gfloat* W, int ldw, int n0, gu8* WQ, gfloat* SB, size_t row_base, int par) {
    float* scr = (float*)(F.sm + F.wave * 16896);
    float* cm = (float*)(F.sm + 135168 + par * 1024);
    const int nl = F.lane & 31, kh = F.lane >> 5;
    const gfloat* src = W + (size_t)(128 * F.wave + kh) * ldw + n0 + nl;
    float mx = 0.f;
#pragma unroll 16
    for (int i = 0; i < 64; ++i) { const float x = src[(size_t)(2 * i) * ldw]; scr[(2 * i + kh) * 33 + nl] = x; mx = fmaxf(mx, fabsf(x)); }
    mx = fmaxf(mx, shfl_xor_l(mx, 32, F.lane));
    if (F.lane < 32) cm[F.wave * 32 + nl] = mx;
    __syncthreads();
    const int c = F.lane & 7;
#pragma unroll
    for (int j = 0; j < 4; ++j) { const int n = (F.lane >> 3) + 8 * j;
        float m = cm[n];
#pragma unroll
        for (int w = 1; w < 8; ++w) m = fmaxf(m, cm[w * 32 + n]);
        m = fmaxf(m, 1e-30f);
        const float inv = 127.f / m;
        const float* sp = scr + (16 * c) * 33 + n;
        u32x4 o;
        o.x = pkq4(sp[0 * 33] * inv, sp[1 * 33] * inv, sp[2 * 33] * inv, sp[3 * 33] * inv);
        o.y = pkq4(sp[4 * 33] * inv, sp[5 * 33] * inv, sp[6 * 33] * inv, sp[7 * 33] * inv);
        o.z = pkq4(sp[8 * 33] * inv, sp[9 * 33] * inv, sp[10 * 33] * inv, sp[11 * 33] * inv);
        o.w = pkq4(sp[12 * 33] * inv, sp[13 * 33] * inv, sp[14 * 33] * inv, sp[15 * 33] * inv);
        *(GAS u32x4*)(WQ + (row_base + n) * (size_t)1024 + 128 * F.wave + 16 * c) = o;
        if (F.wave == 0 && c == 0) SB[row_base + n] = m * (1.f / 127.f); }
    asm volatile("s_waitcnt lgkmcnt(0)" ::: "memory");
}

__device__ __forceinline__ void p0_prologue(Frame& F) {
    float* scr = (float*)(F.sm + F.wave * 16384);
    const int gw = F.bid * NWAVES + F.wave, NGW = F.G * NWAVES;
    {
        constexpr int NB_ML = ML_N / 32, NB_SW = SW_N / 32, NIT = 2 * (NB_ML + NB_SW);
        int par = 0;
        for (int it = F.bid; it < NIT; it += F.G, par ^= 1) {
            const int j = it / (NB_ML + NB_SW), r = it - j * (NB_ML + NB_SW);
            if (r < NB_ML) quant_item_wg(F, FIN(6) + (size_t)j * D * ML_IN, ML_IN, 32 * r, WSP(unsigned char, WS_WMLIN) + (size_t)j * ML_N * D, WSP(float, WS_SBIN) + j * ML_N, (size_t)(32 * r), par);
            else quant_item_wg(F, FIN(10) + (size_t)j * D * SW_N, SW_N, 32 * (r - NB_ML), WSP(unsigned char, WS_WSWIN) + (size_t)j * SW_N * D, WSP(float, WS_SBIN) + 8192 + j * SW_N, (size_t)(32 * (r - NB_ML)), par);
        }
        for (int it = F.bid; it < 4 * 32; it += F.G, par ^= 1) {
            const int mj = it >> 5, nb = it & 31, jj = mj & 1;
            if (mj < 2) quant_item_wg(F, FIN(9) + (size_t)jj * D * D, D, 32 * nb, WSP(unsigned char, WS_WMLOUT) + (size_t)jj * D * D, WSP(float, WS_SBOUT) + jj * D, (size_t)(32 * nb), par);
            else quant_item_wg(F, FIN(14) + (size_t)jj * D * D, D, 32 * nb, WSP(unsigned char, WS_WSWOUT) + (size_t)jj * D * D, WSP(float, WS_SBOUT) + 2 * D + jj * D, (size_t)(32 * nb), par);
        }
        __syncthreads();
    }
    {
        constexpr int I2 = 6 * 32;
        const int NIT = DEPTH * NE * I2;
        for (int it = gw; it < NIT; it += NGW) {
            const int le = it / I2; const int r = it - le * I2;
            const int kb = r / 32, n0 = 32 * (r % 32);
            const gfloat* W = FIN(21) + (size_t)le * DE * D;
            transpose_item(W, D, 64 * kb, n0, WSP(bf16_t, WS_W2), DE, (size_t)le * D + n0, scr, F.lane);
        }
        __syncthreads();
        {
            const int NITQ = DEPTH * NE * 24;
            int par = 0;
            for (int it = F.bid; it < NITQ; it += F.G, par ^= 1) {
                const int le = it / 24, r = it - le * 24, which = r / 12, n0 = 32 * (r % 12);
                const gfloat* W = FIN(which ? 20 : 19) + (size_t)le * D * DE;
                const size_t rb = (size_t)le * 768 + (size_t)(n0 / 128) * 256 + (which ? 128 : 0) + (n0 % 128);
                quant_item_wg(F, W, DE, n0, WSP(unsigned char, WS_W13), WSP(float, WS_SB13), rb, par);
            }
        }
        __syncthreads();
    }
    {
        const int gt = F.bid * NTHREADS + F.tid, NGT = F.G * NTHREADS;
        for (int idx = gt; idx < DEPTH * NRT * D; idx += NGT) {
            const int l = idx / (NRT * D), rem = idx - l * NRT * D, n = rem / D, k = rem - n * D;
            float v = 0.f;
            if (n < 8) v = FIN(15)[((size_t)l * D + k) * 8 + n]; else if (n < 72) v = FIN(17)[((size_t)l * D + k) * 64 + (n - 8)];
            WSP(bf16_t, WS_WRT)[idx] = (bf16_t)f2bf(v);
        }
        for (int idx = gt; idx < 2 * 16 * D; idx += NGT) {
            const int j = idx / (16 * D), rem = idx - j * 16 * D, n = rem / D, k = rem - n * D;
            float v = 0.f;
            if (n < 8) v = FIN(6)[((size_t)j * D + k) * ML_IN + ML_N + n];
            WSP(bf16_t, WS_WMLG)[idx] = (bf16_t)f2bf(v);
        }
    }
    {
        const int NIT = DEPTH * 16 * 96;
        for (int it = gw; it < NIT; it += NGW) {
            const int l = it / (16 * 96), rem = it - l * 16 * 96, kc = rem / 96, jc = rem - kc * 96;
            const int j = jc * 64 + F.lane;
            const gfloat* W = FIN(2) + ((size_t)l * D + kc * 64) * 6144 + j;
            float a0 = 0.f, a1 = 0.f, a2 = 0.f, a3 = 0.f;
#pragma unroll 8
            for (int k = 0; k < 64; ++k) {
                const float w = W[(size_t)k * 6144];
                const int kk = kc * 64 + k;
                const float c0 = FIN(1)[kk], c1 = FIN(1)[D + kk], c2 = FIN(1)[2 * D + kk], c3 = FIN(1)[3 * D + kk];
                a0 += c0 * sigmoidf_(c0) * w; a1 += c1 * sigmoidf_(c1) * w; a2 += c2 * sigmoidf_(c2) * w; a3 += c3 * sigmoidf_(c3) * w;
            }
            gfloat* o = WSP(float, WS_MODP) + (((size_t)kc * DEPTH + l) * 4) * 6144 + j;
            o[0] = a0; o[6144] = a1; o[2 * 6144] = a2; o[3 * 6144] = a3;
        }
    }
}
__device__ __forceinline__ void p0b_modfinal(Frame& F) {
    const int gt = F.bid * NTHREADS + F.tid, NGT = F.G * NTHREADS;
    for (int idx = gt; idx < DEPTH * 4 * 6144; idx += NGT) {
        const int l = idx / (4 * 6144), j = idx % 6144;
        float s = FIN(3)[l * 6144 + j];
#pragma unroll
        for (int kc = 0; kc < 16; ++kc) s += WSP(float, WS_MODP)[(size_t)kc * DEPTH * 4 * 6144 + idx];
        WSP(float, WS_MOD)[idx] = s;
    }
}

__device__ __forceinline__ void build_moe_tables(Frame& F, int layer) {
    int* blk2e = (int*)(F.sm + TAB_BLK2E); int* blkstart = (int*)(F.sm + TAB_BLKSTART); int* cnt = (int*)(F.sm + TAB_CNT); int* nblk = (int*)(F.sm + TAB_NBLK);
    __syncthreads();
    if (F.wave == 0) {
        const int c = (int)__hip_atomic_load(F.ctl + CW_CNT + 64 * layer + F.lane, __ATOMIC_RELAXED, __HIP_MEMORY_SCOPE_AGENT);
        const int nb = (c + 255) >> 8;
        int s = nb;
#pragma unroll
        for (int o = 1; o < 64; o <<= 1) { const int t = __builtin_amdgcn_ds_bpermute((F.lane - o) << 2, s); if (F.lane >= o) s += t; }
        const int st = s - nb;
        cnt[F.lane] = c; blkstart[F.lane] = st;
        for (int j = 0; j < nb; ++j) blk2e[st + j] = F.lane;
        if (F.lane == 63) { blkstart[NE] = s; nblk[0] = s; }
        const int nlab = (F.G % 8 == 0) ? 8 : 1, lab = F.bid % nlab;
        const bool mine = (F.lane % nlab) == lab;
        int q = mine ? nb : 0;
#pragma unroll
        for (int o = 1; o < 64; o <<= 1) { const int t = __builtin_amdgcn_ds_bpermute((F.lane - o) << 2, q); if (F.lane >= o) q += t; }
        int* xblk = (int*)(F.sm + TAB_XBLK);
        if (mine) for (int jj = 0; jj < nb; ++jj) xblk[q - nb + jj] = st + jj;
        if (F.lane == 63) nblk[1] = q;
    }
    __syncthreads();
}

template <int MODE>
__device__ __forceinline__ void normp_phase(Frame& F, int layer, int sub, bool combine) {
    constexpr int RG = 2;
    float* LG = (float*)(F.sm);
    int* lcnt = (int*)(F.sm + 40960);
    int* lbase = lcnt + 64;
    const bool first = (layer == 0 && sub == 0);
    const bool wr_x = combine || first;
    gbf16* xb = WSP(bf16_t, WS_XB);
    const gbf16* xbin = WSP(bf16_t, WS_XB);
    const gfloat* gain = FIN(sub ? 5 : 4) + (size_t)layer * D;
    if (combine) build_moe_tables(F, layer - 1);
    const int* blkstart = (const int*)(F.sm + TAB_BLKSTART);
    const gu8* YS = WSP(unsigned char, WS_YS); const gfloat* YSc = WSP(float, WS_YSS);
    gbf16* HN = WSP(bf16_t, WS_HN);
    gu32* HNQ = WSP(unsigned, WS_HNQ); gfloat* SA = WSP(float, WS_SA);
    for (int rb = F.bid; rb < T / 128; rb += F.G) {
        const int row0 = rb * 128, b = row0 / SEQ;
        const gfloat* modb = WSP(float, WS_MOD) + ((size_t)layer * 4 + b) * 6144;
        const gfloat* shp = modb + (sub ? 3 : 0) * D; const gfloat* scp = shp + D;
        const gfloat* gtp = WSP(float, WS_MOD) + ((size_t)(layer > 0 ? layer - 1 : 0) * 4 + b) * 6144 + 5 * D;
        f32x4 ga[4], sh[4], gt[4];
#pragma unroll
        for (int j = 0; j < 4; ++j) { const int col = 4 * F.lane + 256 * j;
            const f32x4 g = *(const GAS f32x4*)(gain + col), sc = *(const GAS f32x4*)(scp + col);
            ga[j] = g * (sc + 1.f); sh[j] = *(const GAS f32x4*)(shp + col); gt[j] = combine ? *(const GAS f32x4*)(gtp + col) : (f32x4){0.f, 0.f, 0.f, 0.f}; }
        unsigned ti0 = 0u, ti1 = 0u; float tg0 = 0.f, tg1 = 0.f;
        if (combine && F.lane < 16) { const int row = row0 + 16 * F.wave + F.lane;
            const u32x2 ti = *(const GAS u32x2*)(WSP(unsigned, WS_TOKINFO) + row * 2); const f32x2 tg = *(const GAS f32x2*)(WSP(float, WS_TOKGATE) + row * 2);
            ti0 = ti.x; ti1 = ti.y; tg0 = tg.x; tg1 = tg.y; }
        for (int grp = 0; grp < 16 / RG; ++grp) {
            const int rbase = row0 + 16 * F.wave + RG * grp;
            f32x4 v[RG][4];
#pragma unroll
            for (int i = 0; i < RG; ++i)
#pragma unroll
                for (int j = 0; j < 4; ++j) v[i][j] = (f32x4){0.f, 0.f, 0.f, 0.f};
            u32x2 xw[RG][4];
#pragma unroll
            for (int i = 0; i < RG; ++i)
#pragma unroll
                for (int j = 0; j < 4; ++j) xw[i][j] = (u32x2){0u, 0u};
            if (first) {
#pragma unroll
                for (int i = 0; i < RG; ++i)
#pragma unroll
                    for (int j = 0; j < 4; ++j) v[i][j] = *(const GAS f32x4*)(FIN(0) + (size_t)(rbase + i) * D + 4 * F.lane + 256 * j);
            } else {
#pragma unroll
                for (int i = 0; i < RG; ++i)
#pragma unroll
                    for (int j = 0; j < 4; ++j) xw[i][j] = *(const GAS u32x2*)(xbin + (size_t)(rbase + i) * D + 4 * F.lane + 256 * j);
            }
            if (combine) {
                unsigned y0[RG][4], y1[RG][4]; float z0[RG][4], z1[RG][4]; float g0[RG], g1[RG];
#pragma unroll
                for (int i = 0; i < RG; ++i) {
                    const int li = RG * grp + i;
                    const unsigned i0 = (unsigned)__builtin_amdgcn_readlane((int)ti0, li), i1 = (unsigned)__builtin_amdgcn_readlane((int)ti1, li);
                    g0[i] = __int_as_float(__builtin_amdgcn_readlane(__float_as_int(tg0), li)); g1[i] = __int_as_float(__builtin_amdgcn_readlane(__float_as_int(tg1), li));
                    const size_t s0 = (size_t)blkstart[i0 >> 16] * 256 + (i0 & 0xffffu), s1 = (size_t)blkstart[i1 >> 16] * 256 + (i1 & 0xffffu);
#pragma unroll
                    for (int j = 0; j < 4; ++j) { y0[i][j] = *(const GAS unsigned*)(YS + s0 * D + 4 * F.lane + 256 * j); y1[i][j] = *(const GAS unsigned*)(YS + s1 * D + 4 * F.lane + 256 * j);
                        z0[i][j] = YSc[s0 * 32 + 8 * j + (F.lane >> 3)]; z1[i][j] = YSc[s1 * 32 + 8 * j + (F.lane >> 3)]; }
                }
                asm volatile("" ::: "memory");
#pragma unroll
                for (int i = 0; i < RG; ++i)
#pragma unroll
                    for (int j = 0; j < 4; ++j) {
                        if (!first) v[i][j] = (f32x4){bf2f(xw[i][j].x & 0xffffu), bf2f(xw[i][j].x >> 16), bf2f(xw[i][j].y & 0xffffu), bf2f(xw[i][j].y >> 16)};
                        v[i][j] += gt[j] * (unq4(y0[i][j], g0[i] * z0[i][j]) + unq4(y1[i][j], g1[i] * z1[i][j]));
                    }
            }
            if (!combine && !first) {
#pragma unroll
                for (int i = 0; i < RG; ++i)
#pragma unroll
                    for (int j = 0; j < 4; ++j) v[i][j] = (f32x4){bf2f(xw[i][j].x & 0xffffu), bf2f(xw[i][j].x >> 16), bf2f(xw[i][j].y & 0xffffu), bf2f(xw[i][j].y >> 16)};
            }
            float ss[RG];
#pragma unroll
            for (int i = 0; i < RG; ++i) { ss[i] = 0.f;
#pragma unroll
                for (int j = 0; j < 4; ++j) {
                    if (wr_x) { u32x2 xw; xw.x = pk2(v[i][j].x, v[i][j].y); xw.y = pk2(v[i][j].z, v[i][j].w); *(GAS u32x2*)(xb + (size_t)(rbase + i) * D + 4 * F.lane + 256 * j) = xw;
                        v[i][j] = (f32x4){bf2f(xw.x & 0xffffu), bf2f(xw.x >> 16), bf2f(xw.y & 0xffffu), bf2f(xw.y >> 16)}; }
                    ss[i] += (v[i][j].x * v[i][j].x + v[i][j].y * v[i][j].y) + (v[i][j].z * v[i][j].z + v[i][j].w * v[i][j].w); } }
#pragma unroll
            for (int o = 1; o < 64; o <<= 1) {
#pragma unroll
                for (int i = 0; i < RG; ++i) ss[i] += shfl_xor_l(ss[i], o, F.lane); }
            float mx[RG];
#pragma unroll
            for (int i = 0; i < RG; ++i) { const float r = rsqrtf(ss[i] * (1.f / D) + EPS); mx[i] = 0.f;
#pragma unroll
                for (int j = 0; j < 4; ++j) { const f32x4 hv = v[i][j] * r * ga[j] + sh[j]; v[i][j] = hv;
                    mx[i] = fmaxf(fmaxf(mx[i], fmaxf(fabsf(hv.x), fabsf(hv.y))), fmaxf(fabsf(hv.z), fabsf(hv.w)));
                    if (MODE != 0) { u32x2 w; w.x = pk2(hv.x, hv.y); w.y = pk2(hv.z, hv.w);
                        *(GAS u32x2*)(HN + (size_t)(rbase + i) * D + 4 * F.lane + 256 * j) = w; } } }
#pragma unroll
            for (int o = 1; o < 64; o <<= 1) {
#pragma unroll
                for (int i = 0; i < RG; ++i) mx[i] = fmaxf(mx[i], shfl_xor_l(mx[i], o, F.lane)); }
#pragma unroll
            for (int i = 0; i < RG; ++i) { const float m_ = fmaxf(mx[i], 1e-30f), inv = 127.f * frcp(m_);
#pragma unroll
                for (int j = 0; j < 4; ++j) HNQ[(size_t)(rbase + i) * (D / 4) + F.lane + 64 * j] = pkq4(v[i][j].x * inv, v[i][j].y * inv, v[i][j].z * inv, v[i][j].w * inv);
                if (F.lane == 0) SA[rbase + i] = m_ * (1.f / 127.f); }
        }
        if (MODE != 0) {
            asm volatile("s_waitcnt vmcnt(0)" ::: "memory");
            __syncthreads();
            __builtin_amdgcn_fence(__ATOMIC_ACQUIRE, "agent");
            constexpr int NTP = 1;
            const gbf16* WT = WSP(bf16_t, WS_WMLG) + (size_t)(layer >> 1) * 16 * D;
            const int fr = F.lane & 15, fq = F.lane >> 4;
            f32x4 acc[NTP];
#pragma unroll
            for (int n = 0; n < NTP; ++n) acc[n] = (f32x4){0.f, 0.f, 0.f, 0.f};
            const GAS char* ab = (const GAS char*)(HN + (size_t)(row0 + 16 * F.wave) * D);
            const GAS char* wb = (const GAS char*)WT;
            const unsigned lo = (unsigned)(fr * D + fq * 8) * 2u;
            for (int k0 = 0; k0 < 32; k0 += 4) {
                bf16x8 a[4], bb[4][NTP];
                unsigned lo2 = lo; asm volatile("" : "+v"(lo2));
#pragma unroll
                for (int i = 0; i < 4; ++i) { a[i] = *(const GAS bf16x8*)(ab + (size_t)(k0 + i) * 64 + lo2);
#pragma unroll
                    for (int n = 0; n < NTP; ++n) bb[i][n] = *(const GAS bf16x8*)(wb + (size_t)n * 16 * D * 2 + (size_t)(k0 + i) * 64 + lo2); }
                asm volatile("" ::: "memory"); __builtin_amdgcn_sched_barrier(0);
#pragma unroll
                for (int i = 0; i < 4; ++i)
#pragma unroll
                    for (int n = 0; n < NTP; ++n) acc[n] = __builtin_amdgcn_mfma_f32_16x16x32_bf16(a[i], bb[i][n], acc[n], 0, 0, 0);
                __builtin_amdgcn_sched_barrier(0);
            }
#pragma unroll
            for (int n = 0; n < NTP; ++n)
#pragma unroll
                for (int j = 0; j < 4; ++j) LG[(16 * F.wave + 4 * fq + j) * NRT + n * 16 + fr] = acc[n][j];
            __syncthreads();
            {
                for (int idx = F.tid; idx < 128 * 8; idx += NTHREADS) {
                    const int r = idx >> 3, gi = idx & 7, row = row0 + r;
                    float z = LG[r * NRT + gi] + FIN(7)[(layer >> 1) * 8 + gi];
                    z = GATE_CAP * (1.f - 2.f / (__expf(z * (2.f / GATE_CAP)) + 1.f));
                    if (gi < 4) WSP(float, WS_IG)[row * 4 + gi] = z;
                    else WSP(float, WS_LF)[row * 4 + gi - 4] = fminf(z, 0.f) - __logf(1.f + __expf(-fabsf(z)));
                }
                __syncthreads();
            }
        }
    }
}

__device__ __forceinline__ void normp_router(Frame& F, int layer) {
    constexpr int WS_ = 528;
    constexpr int WB_OFF = 0, LG_OFF = 80 * WS_, GA_OFF = LG_OFF + 128 * NRT * 4, SH_OFF = GA_OFF + 4096, BI_OFF = SH_OFF + 4096, LC_OFF = BI_OFF + 512;
    float* LG = (float*)(F.sm + LG_OFF); float* GA = (float*)(F.sm + GA_OFF); float* SH = (float*)(F.sm + SH_OFF); float* BI = (float*)(F.sm + BI_OFF);
    int* lcnt = (int*)(F.sm + LC_OFF); int* lbase = lcnt + 64; float* RS = (float*)(F.sm + LC_OFF + 512);
    LAS unsigned char* L = F.lds;
    const gbf16* XBp = WSP(bf16_t, WS_XB); gu8* HNQ = WSP(unsigned char, WS_HNQ);
    const gbf16* WT = WSP(bf16_t, WS_WRT) + (size_t)layer * NRT * D;
    const int fr = F.lane & 15, fq = F.lane >> 4;
    for (int rb = F.bid; rb < T / 128; rb += F.G) {
        const int row0 = rb * 128, b = row0 / SEQ;
        const gfloat* modb = WSP(float, WS_MOD) + ((size_t)layer * 4 + b) * 6144;
        __syncthreads();
        for (int i = F.tid; i < D / 4; i += NTHREADS) { const f32x4 g = *(const GAS f32x4*)(FIN(5) + (size_t)layer * D + 4 * i), sc = *(const GAS f32x4*)(modb + 4 * D + 4 * i);
            *(f32x4*)(GA + 4 * i) = g * (sc + 1.f); *(f32x4*)(SH + 4 * i) = *(const GAS f32x4*)(modb + 3 * D + 4 * i); }
        if (F.tid < 72) BI[F.tid] = (F.tid < 8) ? FIN(16)[layer * 8 + F.tid] : FIN(18)[layer * 64 + F.tid - 8];
        if (F.tid < 64) lcnt[F.tid] = 0;
        const int row = row0 + 16 * F.wave + fr;
        const GAS char* xr = (const GAS char*)(XBp + (size_t)row * D + 8 * fq);
        float ss = 0.f;
#pragma unroll
        for (int j0 = 0; j0 < 32; j0 += 8) {
            u32x4 xw[8];
#pragma unroll
            for (int j = 0; j < 8; ++j) xw[j] = *(const GAS u32x4*)(xr + (size_t)(j0 + j) * 64);
#pragma unroll
            for (int j = 0; j < 8; ++j) { float f[8]; unpack8(xw[j], f);
#pragma unroll
                for (int e = 0; e < 8; ++e) ss += f[e] * f[e]; }
        }
        ss += shfl_xor_l(ss, 16, F.lane); ss += shfl_xor_l(ss, 32, F.lane);
        const float r = rsqrtf(ss * (1.f / D) + EPS);
        f32x4 acc[5];
#pragma unroll
        for (int n = 0; n < 5; ++n) acc[n] = (f32x4){0.f, 0.f, 0.f, 0.f};
        float hmx = 0.f;
        __syncthreads();
#pragma unroll
        for (int j0 = 0; j0 < 32; j0 += 8) {
            u32x4 xw[8];
#pragma unroll
            for (int j = 0; j < 8; ++j) xw[j] = *(const GAS u32x4*)(xr + (size_t)(j0 + j) * 64);
#pragma unroll
            for (int j = 0; j < 8; ++j) { float f[8]; unpack8(xw[j], f);
                const int col = 32 * (j0 + j) + 8 * fq;
                const f32x4 g0 = *(const f32x4*)(GA + col), g1 = *(const f32x4*)(GA + col + 4), s0 = *(const f32x4*)(SH + col), s1 = *(const f32x4*)(SH + col + 4);
#pragma unroll
                for (int e = 0; e < 4; ++e) hmx = fmaxf(hmx, fmaxf(fabsf(f[e] * r * g0[e] + s0[e]), fabsf(f[4 + e] * r * g1[e] + s1[e]))); }
        }
        hmx = fmaxf(hmx, shfl_xor_l(hmx, 16, F.lane)); hmx = fmaxf(hmx, shfl_xor_l(hmx, 32, F.lane));
        const float m_ = fmaxf(hmx, 1e-30f), inv = 127.f * frcp(m_);
        if (fq == 0) RS[16 * F.wave + fr] = m_ * (1.f / 127.f);
        GAS char* qr = (GAS char*)HNQ + (size_t)row * D;
        for (int kc = 0; kc < 4; ++kc) {
            __syncthreads();
#pragma unroll
            for (int i = 0; i < 5; ++i) { const int idx = F.tid + NTHREADS * i, n = idx >> 5, c16 = idx & 31;
                *(u32x4*)(F.sm + WB_OFF + n * WS_ + c16 * 16) = *(const GAS u32x4*)(WT + (size_t)n * D + 256 * kc + 8 * c16); }
            u32x4 xw[8];
#pragma unroll
            for (int j = 0; j < 8; ++j) xw[j] = *(const GAS u32x4*)(xr + (size_t)(8 * kc + j) * 64);
            __syncthreads();
#pragma unroll
            for (int j = 0; j < 8; ++j) {
                const int col = 256 * kc + 32 * j + 8 * fq;
                float f[8]; unpack8(xw[j], f);
                const f32x4 g0 = *(const f32x4*)(GA + col), g1 = *(const f32x4*)(GA + col + 4), s0 = *(const f32x4*)(SH + col), s1 = *(const f32x4*)(SH + col + 4);
                float h[8];
#pragma unroll
                for (int e = 0; e < 4; ++e) { h[e] = f[e] * r * g0[e] + s0[e]; h[4 + e] = f[4 + e] * r * g1[e] + s1[e]; }
                u32x4 hw;
                hw.x = pk2(h[0], h[1]); hw.y = pk2(h[2], h[3]); hw.z = pk2(h[4], h[5]); hw.w = pk2(h[6], h[7]);
                { u32x2 q; q.x = pkq4(h[0] * inv, h[1] * inv, h[2] * inv, h[3] * inv); q.y = pkq4(h[4] * inv, h[5] * inv, h[6] * inv, h[7] * inv);
                  *(GAS u32x2*)(qr + col) = q; }
                const bf16x8 a = __builtin_bit_cast(bf16x8, hw);
                bf16x8 bb[5];
#pragma unroll
                for (int n = 0; n < 5; ++n) bb[n] = *(const LAS bf16x8*)(L + WB_OFF + (16 * n + fr) * WS_ + (32 * j + 8 * fq) * 2);
#pragma unroll
                for (int n = 0; n < 5; ++n) acc[n] = __builtin_amdgcn_mfma_f32_16x16x32_bf16(a, bb[n], acc[n], 0, 0, 0);
            }
        }
#pragma unroll
        for (int n = 0; n < 5; ++n)
#pragma unroll
            for (int jj = 0; jj < 4; ++jj) LG[(16 * F.wave + 4 * fq + jj) * NRT + n * 16 + fr] = acc[n][jj];
        __syncthreads();
        int e0 = 0, e1 = 0, lr0 = 0, lr1 = 0; float gate0 = 0.f, gate1 = 0.f;
        if (F.tid < 128) {
            const float* lg = LG + F.tid * NRT;
            float gl[8]; int gs = 0; float mx = -INFINITY;
#pragma unroll
            for (int jj = 0; jj < 8; ++jj) { gl[jj] = lg[jj] + BI[jj]; if (gl[jj] > mx) { mx = gl[jj]; gs = jj; } }
            float se = 0.f;
#pragma unroll
            for (int jj = 0; jj < 8; ++jj) se += __expf(gl[jj] - mx);
            const float pg = 1.f / se;
            float el[8]; int t1 = 0; float v0 = -INFINITY;
#pragma unroll
            for (int jj = 0; jj < 8; ++jj) { el[jj] = lg[8 + gs * 8 + jj] + BI[8 + gs * 8 + jj]; if (el[jj] > v0) { v0 = el[jj]; t1 = jj; } }
            int t2 = 0; float v1 = -INFINITY;
#pragma unroll
            for (int jj = 0; jj < 8; ++jj) if (jj != t1 && el[jj] > v1) { v1 = el[jj]; t2 = jj; }
            const float ex = __expf(v1 - v0);
            gate0 = pg / (1.f + ex); gate1 = pg * ex / (1.f + ex);
            e0 = gs * 8 + t1; e1 = gs * 8 + t2;
            lr0 = atomicAdd(&lcnt[e0], 1); lr1 = atomicAdd(&lcnt[e1], 1);
        }
        __syncthreads();
        if (F.tid < 64) { const int c = lcnt[F.tid]; lbase[F.tid] = c > 0 ? (int)__hip_atomic_fetch_add(F.ctl + CW_CNT + 64 * layer + F.tid, (unsigned)c, __ATOMIC_RELAXED, __HIP_MEMORY_SCOPE_AGENT) : 0; }
        __syncthreads();
        if (F.tid < 128) {
            const int rw = row0 + F.tid;
            const int r0 = lbase[e0] + lr0, r1 = lbase[e1] + lr1;
            WSP(unsigned, WS_LIST)[(size_t)e0 * CAP + r0] = (unsigned)rw;
            WSP(unsigned, WS_LIST)[(size_t)e1 * CAP + r1] = (unsigned)rw;
            WSP(unsigned, WS_TOKINFO)[rw * 2] = ((unsigned)e0 << 16) | (unsigned)r0;
            WSP(unsigned, WS_TOKINFO)[rw * 2 + 1] = ((unsigned)e1 << 16) | (unsigned)r1;
            WSP(float, WS_TOKGATE)[rw * 2] = gate0; WSP(float, WS_TOKGATE)[rw * 2 + 1] = gate1;
            const float rs = RS[F.tid];
            WSP(float, WS_SAE)[(size_t)e0 * CAP + r0] = rs; WSP(float, WS_SAE)[(size_t)e1 * CAP + r1] = rs;
        }
    }
    __syncthreads();
}

__device__ __forceinline__ void final_phase(Frame& F) {
    build_moe_tables(F, DEPTH - 1);
    const int* blkstart = (const int*)(F.sm + TAB_BLKSTART);
    const gu8* YS = WSP(unsigned char, WS_YS); const gfloat* YSc = WSP(float, WS_YSS);
    const int gw = F.bid * NWAVES + F.wave, NGW = F.G * NWAVES;
    constexpr int NR = 4;
    for (int row0 = NR * gw; row0 < T; row0 += NR * NGW) {
        const int b = row0 / SEQ;
        const gfloat* gtp = WSP(float, WS_MOD) + ((size_t)(DEPTH - 1) * 4 + b) * 6144 + 5 * D;
        u32x2 xw[NR][4]; unsigned y0[NR][4], y1[NR][4]; float z0[NR][4], z1[NR][4]; float g0[NR], g1[NR]; f32x4 gt[4];
#pragma unroll
        for (int i = 0; i < NR; ++i) {
            const int row = row0 + i;
            const unsigned i0 = WSP(unsigned, WS_TOKINFO)[row * 2], i1 = WSP(unsigned, WS_TOKINFO)[row * 2 + 1];
            g0[i] = WSP(float, WS_TOKGATE)[row * 2]; g1[i] = WSP(float, WS_TOKGATE)[row * 2 + 1];
            const size_t s0 = (size_t)blkstart[i0 >> 16] * 256 + (i0 & 0xffffu), s1 = (size_t)blkstart[i1 >> 16] * 256 + (i1 & 0xffffu);
#pragma unroll
            for (int j = 0; j < 4; ++j) {
                xw[i][j] = *(const GAS u32x2*)(WSP(bf16_t, WS_XB) + (size_t)row * D + 4 * F.lane + 256 * j);
                y0[i][j] = *(const GAS unsigned*)(YS + s0 * D + 4 * F.lane + 256 * j); y1[i][j] = *(const GAS unsigned*)(YS + s1 * D + 4 * F.lane + 256 * j);
                z0[i][j] = YSc[s0 * 32 + 8 * j + (F.lane >> 3)]; z1[i][j] = YSc[s1 * 32 + 8 * j + (F.lane >> 3)]; }
        }
#pragma unroll
        for (int j = 0; j < 4; ++j) gt[j] = *(const GAS f32x4*)(gtp + 4 * F.lane + 256 * j);
#pragma unroll
        for (int i = 0; i < NR; ++i)
#pragma unroll
            for (int j = 0; j < 4; ++j) {
                f32x4 v = (f32x4){bf2f(xw[i][j].x & 0xffffu), bf2f(xw[i][j].x >> 16), bf2f(xw[i][j].y & 0xffffu), bf2f(xw[i][j].y >> 16)};
                v += gt[j] * (unq4(y0[i][j], g0[i] * z0[i][j]) + unq4(y1[i][j], g1[i] * z1[i][j]));
                *(GAS f32x4*)(F.out + (size_t)(row0 + i) * D + 4 * F.lane + 256 * j) = v;
            }
    }
}

__device__ __forceinline__ float shfl_up_l(float v, int o, int lane) { return __int_as_float(__builtin_amdgcn_ds_bpermute((lane - o) << 2, __float_as_int(v))); }
__device__ __forceinline__ float ml_chunk_scalars(Frame& F, float* sc, int tok0, int h) {
    float mall = 0.f;
    if (F.wave == 0) {
        const int l = F.lane;
        const float lf0 = WSP(float, WS_LF)[(size_t)(tok0 + 2 * l) * 4 + h], lf1 = WSP(float, WS_LF)[(size_t)(tok0 + 2 * l + 1) * 4 + h];
        const float ig0 = WSP(float, WS_IG)[(size_t)(tok0 + 2 * l) * 4 + h], ig1 = WSP(float, WS_IG)[(size_t)(tok0 + 2 * l + 1) * 4 + h];
        float s = lf0 + lf1;
#pragma unroll
        for (int o = 1; o < 64; o <<= 1) { const float t = shfl_up_l(s, o, l); if (l >= o) s += t; }
        const float ex = s - (lf0 + lf1);
        const float b0 = ex + lf0, b1 = b0 + lf1, p0 = ig0 - b0, p1 = ig1 - b1;
        float m = fmaxf(p0, p1);
#pragma unroll
        for (int o = 1; o < 64; o <<= 1) { const float t = shfl_up_l(m, o, l); if (l >= o) m = fmaxf(m, t); }
        float mex = shfl_up_l(m, 1, l); if (l == 0) mex = -INFINITY;
        *(f32x2*)(sc + 2 * l) = (f32x2){lf0, lf1}; *(f32x2*)(sc + 128 + 2 * l) = (f32x2){ig0, ig1};
        *(f32x2*)(sc + 256 + 2 * l) = (f32x2){b0, b1}; *(f32x2*)(sc + 384 + 2 * l) = (f32x2){p0, p1};
        *(f32x2*)(sc + 896 + 2 * l) = (f32x2){fmaxf(mex, p0), fmaxf(mex, fmaxf(p0, p1))};
        mall = __int_as_float(__builtin_amdgcn_readlane(__float_as_int(m), 63));
    }
    return mall;
}
__device__ __forceinline__ void ml_s2_phase(Frame& F) {
    constexpr int Q8 = ST_ELEMS / 8, NIT = NBATCH * ML_H * Q8;
    for (int iw = F.wave * F.G + F.bid; iw * 64 < NIT; iw += F.G * NWAVES) {
        const int idx = iw * 64 + F.lane;
        if (idx < NIT) {
            const int bh = idx / Q8, e8 = (idx - bh * Q8) * 8;
            float st[8], m = 0.f;
#pragma unroll
            for (int e = 0; e < 8; ++e) st[e] = 0.f;
            for (int c0 = 0; c0 < NCH; c0 += 16) {
                u32x4 w[16]; f32x2 ga[16];
#pragma unroll
                for (int k = 0; k < 16; ++k) { const int u = bh * NCH + c0 + k; w[k] = *(const GAS u32x4*)(WSP(bf16_t, WS_UST) + (size_t)u * ST_ELEMS + e8); ga[k] = *(const GAS f32x2*)(WSP(float, WS_CS) + u * 2); }
                asm volatile("" ::: "memory");
#pragma unroll
                for (int k = 0; k < 16; ++k) {
                    const int u = bh * NCH + c0 + k;
                    const float G = ga[k].x, A = ga[k].y;
                    const float mn = fmaxf(G + m, A), decay = __expf(G + m - mn), scale = __expf(A - mn);
                    m = mn;
                    float f[8]; unpack8(w[k], f);
#pragma unroll
                    for (int e = 0; e < 8; ++e) st[e] = decay * st[e] + scale * f[e];
                    u32x4 o; o.x = pk2(st[0], st[1]); o.y = pk2(st[2], st[3]); o.z = pk2(st[4], st[5]); o.w = pk2(st[6], st[7]);
                    st16_wt(WSP(bf16_t, WS_CST) + (size_t)u * ST_ELEMS + e8, o);
                    if (e8 == 0) (WSP(float, WS_CS) + 16384)[u] = m;
                }
            }
        }
    }
}
typedef short v4i16_t __attribute__((ext_vector_type(4)));
__device__ __forceinline__ bf16x8 tr2(const LAS unsigned char* p0, const LAS unsigned char* p1) {
    const v4i16_t x0 = __builtin_amdgcn_ds_read_tr16_b64_v4i16((LAS v4i16_t*)p0), x1 = __builtin_amdgcn_ds_read_tr16_b64_v4i16((LAS v4i16_t*)p1);
    return __builtin_shufflevector(x0, x1, 0, 1, 2, 3, 4, 5, 6, 7);
}
__device__ __forceinline__ bf16x8 scale_frag(bf16x8 q, float s) {
    u32x4 w = __builtin_bit_cast(u32x4, q); float f[8]; unpack8(w, f);
    u32x4 o; o.x = pk2(f[0] * s, f[1] * s); o.y = pk2(f[2] * s, f[3] * s); o.z = pk2(f[4] * s, f[5] * s); o.w = pk2(f[6] * s, f[7] * s);
    return __builtin_bit_cast(bf16x8, o);
}
__device__ __forceinline__ u32x4 q16bf(u32x4 a, u32x4 b, float inv) {
    float f[8], g[8]; unpack8(a, f); unpack8(b, g);
    u32x4 q; q.x = pkq4(f[0] * inv, f[1] * inv, f[2] * inv, f[3] * inv); q.y = pkq4(f[4] * inv, f[5] * inv, f[6] * inv, f[7] * inv);
    q.z = pkq4(g[0] * inv, g[1] * inv, g[2] * inv, g[3] * inv); q.w = pkq4(g[4] * inv, g[5] * inv, g[6] * inv, g[7] * inv);
    return q;
}
__device__ __forceinline__ unsigned rsq4(unsigned w, float r) {
    const int iw = (int)w;
    return pkq4((float)((iw << 24) >> 24) * r, (float)((iw << 16) >> 24) * r, (float)((iw << 8) >> 24) * r, (float)(iw >> 24) * r);
}
template <int SH>
__device__ __forceinline__ void mix_rescale(Frame& F, int tok, int fr, int fq, const float* hsc) {
    constexpr int NH = 16 >> SH;
    float S = 0.f;
#pragma unroll
    for (int h = 0; h < NH; ++h) S = fmaxf(S, hsc[h * 16 + fr]);
    if (fq == 0) WSP(float, WS_SAM)[tok] = S * (1.f / 127.f);
    const float iS = frcp(S);
    GAS char* p = (GAS char*)WSP(unsigned char, WS_MIXQ) + (size_t)tok * D + 16 * fq;
    asm volatile("s_waitcnt vmcnt(0)" ::: "memory");
#pragma unroll
    for (int p0 = 0; p0 < 16; p0 += 8) {
        u32x4 a[8];
#pragma unroll
        for (int i = 0; i < 8; ++i) a[i] = *(const GAS u32x4*)(p + 64 * (p0 + i));
        asm volatile("" ::: "memory");
#pragma unroll
        for (int i = 0; i < 8; ++i) { const float r = hsc[((p0 + i) >> SH) * 16 + fr] * iS;
            u32x4 q; q.x = rsq4(a[i].x, r); q.y = rsq4(a[i].y, r); q.z = rsq4(a[i].z, r); q.w = rsq4(a[i].w, r);
            *(GAS u32x4*)(p + 64 * (p0 + i)) = q; }
    }
}
__device__ __forceinline__ int mix_unit(const Frame& F, int it) { const int blk = F.bid + (it >> 2) * F.G; return blk < T / 128 ? ((((blk >> 6) * 4 + (it & 3)) << 6) + (blk & 63)) : -1; }

__device__ __forceinline__ void ml_s3_mfma(Frame& F, int j) {
    constexpr int QS = 272, VS = 528, Q_OFF = 4096, K_OFF = Q_OFF + 128 * QS, V_OFF = K_OFF + 128 * QS;
    float* sc = (float*)(F.sm);
    LAS unsigned char* L = F.lds;
    const gbf16* P = WSP(bf16_t, WS_PROJ);
    const gfloat* MC = WSP(float, WS_CS) + 16384;
    const int w = F.wave, t0 = 16 * w;
    u32x4 tq[4], tk[4];
#define S3_LOAD(uu) do { const int c_ = (uu) % NCH, bh_ = (uu) / NCH, h_ = bh_ % ML_H, b_ = bh_ / ML_H, tk0_ = b_ * SEQ + c_ * LC; int tl_ = F.tid; asm volatile("" : "+v"(tl_)); \
        _Pragma("unroll") for (int i = 0; i < 4; ++i) { const int idx = tl_ + NTHREADS * i, s = idx >> 4, d8 = (idx & 15) * 8; \
            tq[i] = *(const GAS u32x4*)(P + (size_t)(tk0_ + s) * ML_N + h_ * ML_DK + d8); tk[i] = *(const GAS u32x4*)(P + (size_t)(tk0_ + s) * ML_N + 512 + h_ * ML_DK + d8); } \
        } while (0)
#define S3_LOAD_V(uu) do { const int c_ = (uu) % NCH, bh_ = (uu) / NCH, h_ = bh_ % ML_H, b_ = bh_ / ML_H, tk0_ = b_ * SEQ + c_ * LC; int tl_ = F.tid; asm volatile("" : "+v"(tl_)); \
        _Pragma("unroll") for (int i = 0; i < 8; ++i) { const int idx = tl_ + NTHREADS * i, s = idx >> 5, d8 = (idx & 31) * 8; \
            tv[i] = *(const GAS u32x4*)(P + (size_t)(tk0_ + s) * ML_N + 1024 + h_ * ML_DV + d8); } } while (0)
    { const int u0 = mix_unit(F, 0); if (u0 >= 0) S3_LOAD(u0); }
    float tmx = 0.f;
    for (int it = 0; ; ++it) {
        const int u = mix_unit(F, it); if (u < 0) break;
        const int c = u % NCH, bh = u / NCH, h = bh % ML_H, b = bh / ML_H, tok0 = b * SEQ + c * LC;
        int ln_ = F.lane; asm volatile("" : "+v"(ln_));
        const int fr = ln_ & 15, fq = ln_ >> 4;
        (void)ml_chunk_scalars(F, sc, tok0, h);
        if (F.wave == 0) {
            const float m_in = (c == 0) ? 0.f : MC[u - 1];
            const f32x2 ml = *(const f32x2*)(sc + 896 + 2 * F.lane), bb = *(const f32x2*)(sc + 256 + 2 * F.lane);
            const float mp0 = fmaxf(m_in, ml.x), mp1 = fmaxf(m_in, ml.y);
            *(f32x2*)(sc + 512 + 2 * F.lane) = (f32x2){mp0, mp1};
            *(f32x2*)(sc + 640 + 2 * F.lane) = (f32x2){__expf(m_in - mp0), __expf(m_in - mp1)};
            *(f32x2*)(sc + 768 + 2 * F.lane) = (f32x2){__expf(-(bb.x + mp0)), __expf(-(bb.y + mp1))};
        }
        {
            u32x4 tv[8];
            S3_LOAD_V(u);
            int tl = F.tid; asm volatile("" : "+v"(tl));
#pragma unroll
            for (int i = 0; i < 4; ++i) { const int idx = tl + NTHREADS * i, s = idx >> 4, d8 = (idx & 15) * 8;
                *(u32x4*)(F.sm + Q_OFF + s * QS + d8 * 2) = tq[i]; *(u32x4*)(F.sm + K_OFF + s * QS + d8 * 2) = tk[i]; }
#pragma unroll
            for (int i = 0; i < 8; ++i) { const int idx = tl + NTHREADS * i, s = idx >> 5, d8 = (idx & 31) * 8; *(u32x4*)(F.sm + V_OFF + s * VS + d8 * 2) = tv[i]; }
        }
        __syncthreads();
        const int t = t0 + fr;
        const int tok = tok0 + t;
        const float mp_t = sc[512 + t], wi_t = sc[640 + t], emt_t = sc[768 + t];
        bf16x8 qf[4];
#pragma unroll
        for (int ks = 0; ks < 4; ++ks) qf[ks] = *(const LAS bf16x8*)(L + Q_OFF + t * QS + (32 * ks + 8 * fq) * 2);
        f32x4 acc[16], accd = (f32x4){0.f, 0.f, 0.f, 0.f};
#pragma unroll
        for (int nt = 0; nt < 16; ++nt) acc[nt] = (f32x4){0.f, 0.f, 0.f, 0.f};
        if (c > 0) {
            const GAS char* cb = (const GAS char*)(WSP(bf16_t, WS_CST) + (size_t)(u - 1) * ST_ELEMS);
            const unsigned clo = (unsigned)((16 * (fr >> 2) + (fr & 3)) * ML_DK + 8 * fq) * 2u;
#pragma unroll
            for (int ks = 0; ks < 4; ++ks) {
                const bf16x8 qs = scale_frag(qf[ks], wi_t);
                bf16x8 ca[17];
                unsigned clo2 = clo; asm volatile("" : "+v"(clo2));
#pragma unroll
                for (int nt = 0; nt < 16; ++nt) ca[nt] = *(const GAS bf16x8*)(cb + (size_t)((64 * (nt >> 2) + 4 * (nt & 3)) * ML_DK + 32 * ks) * 2 + clo2);
                ca[16] = *(const GAS bf16x8*)(cb + (size_t)(ML_DV * ML_DK + 32 * ks) * 2 + (clo2 & 0x30u));
                asm volatile("" ::: "memory"); __builtin_amdgcn_sched_barrier(0);
#pragma unroll
                for (int nt = 0; nt < 16; ++nt) acc[nt] = __builtin_amdgcn_mfma_f32_16x16x32_bf16(ca[nt], qs, acc[nt], 0, 0, 0);
                accd = __builtin_amdgcn_mfma_f32_16x16x32_bf16(ca[16], qs, accd, 0, 0, 0);
                __builtin_amdgcn_sched_barrier(0);
            }
        }
        u32x4 ogw[8];
#pragma unroll
        for (int g4 = 0; g4 < 4; ++g4) { ogw[2 * g4] = *(const GAS u32x4*)(P + (size_t)tok * ML_N + 2048 + h * ML_DV + 64 * g4 + 16 * fq); ogw[2 * g4 + 1] = *(const GAS u32x4*)(P + (size_t)tok * ML_N + 2048 + h * ML_DV + 64 * g4 + 16 * fq + 8); }
        const bf16x8 ones = (bf16x8){(short)0x3f80, (short)0x3f80, (short)0x3f80, (short)0x3f80, (short)0x3f80, (short)0x3f80, (short)0x3f80, (short)0x3f80};
        for (int kb = 0; kb <= (w >> 1); ++kb) {
            f32x4 sa = (f32x4){0.f, 0.f, 0.f, 0.f}, sb = (f32x4){0.f, 0.f, 0.f, 0.f};
            {
                bf16x8 ka[4], kc[4];
#pragma unroll
                for (int ks = 0; ks < 4; ++ks) {
                    ka[ks] = *(const LAS bf16x8*)(L + K_OFF + (32 * kb + fr) * QS + (32 * ks + 8 * fq) * 2);
                    kc[ks] = *(const LAS bf16x8*)(L + K_OFF + (32 * kb + 16 + fr) * QS + (32 * ks + 8 * fq) * 2);
                }
                asm volatile("" ::: "memory"); __builtin_amdgcn_sched_barrier(0);
#pragma unroll
                for (int ks = 0; ks < 4; ++ks) {
                    sa = __builtin_amdgcn_mfma_f32_16x16x32_bf16(ka[ks], qf[ks], sa, 0, 0, 0);
                    sb = __builtin_amdgcn_mfma_f32_16x16x32_bf16(kc[ks], qf[ks], sb, 0, 0, 0);
                }
            }
            const f32x4 pa = *(const f32x4*)(sc + 384 + 32 * kb + 4 * fq), pb = *(const f32x4*)(sc + 384 + 32 * kb + 16 + 4 * fq);
            float pw[8];
#pragma unroll
            for (int r = 0; r < 4; ++r) {
                const int s0 = 32 * kb + 4 * fq + r, s1 = s0 + 16;
                pw[r] = (s0 <= t) ? sa[r] * __expf(pa[r] - mp_t) : 0.f;
                pw[4 + r] = (s1 <= t) ? sb[r] * __expf(pb[r] - mp_t) : 0.f;
            }
            u32x4 pk; pk.x = pk2(pw[0], pw[1]); pk.y = pk2(pw[2], pw[3]); pk.z = pk2(pw[4], pw[5]); pk.w = pk2(pw[6], pw[7]);
            const bf16x8 pf = __builtin_bit_cast(bf16x8, pk);
            const LAS unsigned char* vb = L + V_OFF + (32 * kb + 4 * fq + (fr >> 2)) * VS + (16 * (fr & 3)) * 2;
            {
                bf16x8 va[16];
#pragma unroll
                for (int nt = 0; nt < 16; ++nt) { const int co = (64 * (nt >> 2) + 4 * (nt & 3)) * 2; va[nt] = tr2(vb + co, vb + 16 * VS + co); }
                asm volatile("" ::: "memory"); __builtin_amdgcn_sched_barrier(0);
#pragma unroll
                for (int nt = 0; nt < 16; ++nt) acc[nt] = __builtin_amdgcn_mfma_f32_16x16x32_bf16(va[nt], pf, acc[nt], 0, 0, 0);
                accd = __builtin_amdgcn_mfma_f32_16x16x32_bf16(ones, pf, accd, 0, 0, 0);
                __builtin_amdgcn_sched_barrier(0);
            }
        }
        const float dinv = frcp(fmaxf(fabsf(accd[0]), emt_t));
        float ss = 0.f;
#pragma unroll
        for (int nt = 0; nt < 16; ++nt) { acc[nt] = acc[nt] * dinv; ss += (acc[nt][0] * acc[nt][0] + acc[nt][1] * acc[nt][1]) + (acc[nt][2] * acc[nt][2] + acc[nt][3] * acc[nt][3]); }
        ss += shfl_xor_l(ss, 16, F.lane); ss += shfl_xor_l(ss, 32, F.lane);
        const float rinv = rsqrtf(ss * (1.f / ML_DV) + EPS);
        f32x4 gg[16];
#pragma unroll
        for (int g4 = 0; g4 < 4; ++g4)
#pragma unroll
            for (int n4 = 0; n4 < 4; ++n4) gg[4 * g4 + n4] = *(const GAS f32x4*)(FIN(8) + (size_t)j * D + h * ML_DV + 64 * g4 + 16 * fq + 4 * n4);
        u32x4 ow[8];
#pragma unroll
        for (int g4 = 0; g4 < 4; ++g4) {
            float og[16]; { float t8[8]; unpack8(ogw[2 * g4], t8);
#pragma unroll
                for (int i = 0; i < 8; ++i) og[i] = t8[i];
                unpack8(ogw[2 * g4 + 1], t8);
#pragma unroll
                for (int i = 0; i < 8; ++i) og[8 + i] = t8[i]; }
            float r16[16];
#pragma unroll
            for (int n4 = 0; n4 < 4; ++n4)
#pragma unroll
                for (int r = 0; r < 4; ++r) { r16[4 * n4 + r] = acc[4 * g4 + n4][r] * rinv * gg[4 * g4 + n4][r] * sigmoidf_(og[4 * n4 + r]); tmx = fmaxf(tmx, fabsf(r16[4 * n4 + r])); }
            ow[2 * g4].x = pk2(r16[0], r16[1]); ow[2 * g4].y = pk2(r16[2], r16[3]); ow[2 * g4].z = pk2(r16[4], r16[5]); ow[2 * g4].w = pk2(r16[6], r16[7]);
            ow[2 * g4 + 1].x = pk2(r16[8], r16[9]); ow[2 * g4 + 1].y = pk2(r16[10], r16[11]); ow[2 * g4 + 1].z = pk2(r16[12], r16[13]); ow[2 * g4 + 1].w = pk2(r16[14], r16[15]);
        }
        asm volatile("" ::: "memory");
        { const int un = mix_unit(F, it + 1); if (un >= 0) S3_LOAD(un); }
        asm volatile("" ::: "memory");
        {
            float* hsc = (float*)(F.sm + TAB_OFF) + w * 64;
            tmx = fmaxf(tmx, shfl_xor_l(tmx, 16, F.lane)); tmx = fmaxf(tmx, shfl_xor_l(tmx, 32, F.lane));
            const float sh = fmaxf(tmx, 1e-30f), inv = 127.f * frcp(sh);
            if (fq == 0) hsc[(it & 3) * 16 + fr] = sh;
            GAS char* qp = (GAS char*)WSP(unsigned char, WS_MIXQ) + (size_t)tok * D + h * ML_DV + 16 * fq;
#pragma unroll
            for (int g4 = 0; g4 < 4; ++g4) *(GAS u32x4*)(qp + 64 * g4) = q16bf(ow[2 * g4], ow[2 * g4 + 1], inv);
            tmx = 0.f;
            if ((it & 3) == 3) mix_rescale<2>(F, tok, fr, fq, hsc);
        }
        __syncthreads();
    }
}

__device__ __forceinline__ void ml_s1_mfma(Frame& F) {
    constexpr int QS = 272, VS = 528, K_OFF = 4096, V_OFF = K_OFF + 128 * QS;
    float* sc = (float*)(F.sm);
    LAS unsigned char* L = F.lds;
    const gbf16* P = WSP(bf16_t, WS_PROJ);
    const int fr = F.lane & 15, fq = F.lane >> 4, w = F.wave;
    for (int u = F.bid; u < ML_UNITS; u += F.G) {
        const int c = u % NCH, bh = u / NCH, h = bh % ML_H, b = bh / ML_H, tok0 = b * SEQ + c * LC;
        {
            const float Mloc = ml_chunk_scalars(F, sc, tok0, h);
            if (F.wave == 0) {
                const f32x2 p = *(const f32x2*)(sc + 384 + 2 * F.lane);
                *(f32x2*)(sc + 512 + 2 * F.lane) = (f32x2){__expf(p.x - Mloc), __expf(p.y - Mloc)};
                if (F.lane == 63) { const float G = sc[256 + LC - 1]; WSP(float, WS_CS)[u * 2] = G; WSP(float, WS_CS)[u * 2 + 1] = G + Mloc; }
            }
        }
        __syncthreads();
        {
            u32x4 tk[4], tv[8];
            int tl = F.tid; asm volatile("" : "+v"(tl));
#pragma unroll
            for (int i = 0; i < 4; ++i) { const int idx = tl + NTHREADS * i, s = idx >> 4, d8 = (idx & 15) * 8; tk[i] = *(const GAS u32x4*)(P + (size_t)(tok0 + s) * ML_N + 512 + h * ML_DK + d8); }
#pragma unroll
            for (int i = 0; i < 8; ++i) { const int idx = tl + NTHREADS * i, s = idx >> 5, d8 = (idx & 31) * 8; tv[i] = *(const GAS u32x4*)(P + (size_t)(tok0 + s) * ML_N + 1024 + h * ML_DV + d8); }
            asm volatile("" ::: "memory");
#pragma unroll
            for (int i = 0; i < 4; ++i) { const int idx = tl + NTHREADS * i, s = idx >> 4, d8 = (idx & 15) * 8; *(bf16x8*)(F.sm + K_OFF + s * QS + d8 * 2) = scale_frag(__builtin_bit_cast(bf16x8, tk[i]), sc[512 + s]); }
#pragma unroll
            for (int i = 0; i < 8; ++i) { const int idx = tl + NTHREADS * i, s = idx >> 5, d8 = (idx & 31) * 8; *(u32x4*)(F.sm + V_OFF + s * VS + d8 * 2) = tv[i]; }
        }
        __syncthreads();
        bf16x8 bfr[3][4];
        const short one = (fr == 0) ? (short)0x3f80 : (short)0;
#pragma unroll
        for (int ks = 0; ks < 4; ++ks) {
            const LAS unsigned char* vb = L + V_OFF + (32 * ks + 4 * fq + (fr >> 2)) * VS + (4 * (fr & 3)) * 2;
#pragma unroll
            for (int q = 0; q < 2; ++q) bfr[q][ks] = tr2(vb + (16 * (2 * w + q)) * 2, vb + 16 * VS + (16 * (2 * w + q)) * 2);
            bfr[2][ks] = (bf16x8){one, one, one, one, one, one, one, one};
        }
        gbf16* U = WSP(bf16_t, WS_UST) + (size_t)u * ST_ELEMS;
#pragma unroll
        for (int m2 = 0; m2 < 4; ++m2) {
            f32x4 acc[3][2];
#pragma unroll
            for (int q = 0; q < 3; ++q) { acc[q][0] = (f32x4){0.f, 0.f, 0.f, 0.f}; acc[q][1] = (f32x4){0.f, 0.f, 0.f, 0.f}; }
            bf16x8 af[4][2];
#pragma unroll
            for (int ks = 0; ks < 4; ++ks)
#pragma unroll
                for (int mm = 0; mm < 2; ++mm) {
                    const int mt = 2 * m2 + mm;
                    const LAS unsigned char* kb = L + K_OFF + (32 * ks + 4 * fq + (fr >> 2)) * QS + (32 * (fr & 3) + 4 * mt) * 2;
                    af[ks][mm] = tr2(kb, kb + 16 * QS);
                }
            asm volatile("" ::: "memory"); __builtin_amdgcn_sched_barrier(0);
#pragma unroll
            for (int ks = 0; ks < 4; ++ks)
#pragma unroll
                for (int mm = 0; mm < 2; ++mm) {
                    acc[0][mm] = __builtin_amdgcn_mfma_f32_16x16x32_bf16(af[ks][mm], bfr[0][ks], acc[0][mm], 0, 0, 0);
                    acc[1][mm] = __builtin_amdgcn_mfma_f32_16x16x32_bf16(af[ks][mm], bfr[1][ks], acc[1][mm], 0, 0, 0);
                    if (w == 0) acc[2][mm] = __builtin_amdgcn_mfma_f32_16x16x32_bf16(af[ks][mm], bfr[2][ks], acc[2][mm], 0, 0, 0);
                }
            __builtin_amdgcn_sched_barrier(0);
#pragma unroll
            for (int q = 0; q < 3; ++q) {
                if (q == 2 && (w != 0 || fr != 0)) continue;
                const int dv = (q == 2) ? ML_DV : 16 * (2 * w + q) + fr;
                const f32x4 x0 = acc[q][0], x1 = acc[q][1];
                u32x4 o; o.x = pk2(x0[0], x0[1]); o.y = pk2(x0[2], x0[3]); o.z = pk2(x1[0], x1[1]); o.w = pk2(x1[2], x1[3]);
                *(GAS u32x4*)(U + (size_t)dv * ML_DK + 32 * fq + 8 * m2) = o;
            }
        }
        __syncthreads();
    }
}

__device__ __forceinline__ void swa_mfma(Frame& F, int j) {
    constexpr int RS = 144, K_OFF = 0, V_OFF = 272 * RS;
    LAS unsigned char* L = F.lds;
    const gbf16* P = WSP(bf16_t, WS_PROJ);
    const gfloat* gq = FIN(11) + j * SW_DH; const gfloat* gk = FIN(12) + j * SW_DH;
    const int fr = F.lane & 15, fq = F.lane >> 4, w = F.wave;
    constexpr int NU = NBATCH * SW_KVH * (SEQ / 128);
    float* hsc = (float*)(F.sm + 81920) + w * 256;
    for (int it = 0; ; ++it) {
        const int u = mix_unit(F, it); if (u < 0) break;
        const int qb = u % (SEQ / 128), bk = u / (SEQ / 128), hk = bk % SW_KVH, b = bk / SW_KVH;
        const int q0 = qb * 128, k0 = q0 - 128;
        u32x4 tkw[4], tvw[4], qraw[4][2];
        int tl = F.tid; asm volatile("" : "+v"(tl));
        {
            const int tq_ = b * SEQ + q0 + 16 * w + (tl & 15), fq_ = (tl & 63) >> 4;
#pragma unroll
            for (int g = 0; g < 4; ++g) { qraw[g][0] = *(const GAS u32x4*)(P + (size_t)tq_ * SW_N + (hk * 4 + g) * SW_DH + 8 * fq_); qraw[g][1] = *(const GAS u32x4*)(P + (size_t)tq_ * SW_N + (hk * 4 + g) * SW_DH + 32 + 8 * fq_); }
        }
#pragma unroll
        for (int i = 0; i < 4; ++i) { const int idx = tl + NTHREADS * i, s = idx >> 3, d8 = (idx & 7) * 8, pos = k0 + s;
            tkw[i] = (u32x4){0u, 0u, 0u, 0u}; tvw[i] = (u32x4){0u, 0u, 0u, 0u};
            if (pos >= 0) { tkw[i] = *(const GAS u32x4*)(P + (size_t)(b * SEQ + pos) * SW_N + 1024 + hk * SW_DH + d8); tvw[i] = *(const GAS u32x4*)(P + (size_t)(b * SEQ + pos) * SW_N + 1280 + hk * SW_DH + d8); } }
        asm volatile("" ::: "memory");
#pragma unroll
        for (int i = 0; i < 4; ++i) {
            const int idx = tl + NTHREADS * i, s = idx >> 3, d8 = (idx & 7) * 8;
            const u32x4 kw = tkw[i], vw = tvw[i];
            float kf[8]; unpack8(kw, kf);
            float ss = 0.f;
#pragma unroll
            for (int jj = 0; jj < 8; ++jj) ss += kf[jj] * kf[jj];
            ss += shfl_xor_l(ss, 1, F.lane); ss += shfl_xor_l(ss, 2, F.lane); ss += shfl_xor_l(ss, 4, F.lane);
            const float r = rsqrtf(ss * (1.f / SW_DH) + EPS);
            const f32x4 g0 = *(const GAS f32x4*)(gk + d8), g1 = *(const GAS f32x4*)(gk + d8 + 4);
            u32x4 ko; ko.x = pk2(kf[0] * r * g0[0], kf[1] * r * g0[1]); ko.y = pk2(kf[2] * r * g0[2], kf[3] * r * g0[3]);
            ko.z = pk2(kf[4] * r * g1[0], kf[5] * r * g1[1]); ko.w = pk2(kf[6] * r * g1[2], kf[7] * r * g1[3]);
            *(u32x4*)(F.sm + K_OFF + s * RS + d8 * 2) = ko; *(u32x4*)(F.sm + V_OFF + s * RS + d8 * 2) = vw;
        }
        if (F.tid < 16 * 8 * 2) { const int s = 256 + ((F.tid >> 3) & 15), d8 = (F.tid & 7) * 8; unsigned z = 0u; asm volatile("" : "+v"(z)); *(u32x4*)(F.sm + ((F.tid >> 7) ? V_OFF : K_OFF) + s * RS + d8 * 2) = (u32x4){z, z, z, z}; }
        __syncthreads();
        const int tq = b * SEQ + q0 + 16 * w + fr;
        const f32x4 ga0 = *(const GAS f32x4*)(gq + 8 * fq), ga1 = *(const GAS f32x4*)(gq + 8 * fq + 4), gc0 = *(const GAS f32x4*)(gq + 32 + 8 * fq), gc1 = *(const GAS f32x4*)(gq + 32 + 8 * fq + 4);
        const int dq = fr - 4 * fq;
#pragma unroll
        for (int gp = 0; gp < 2; ++gp) {
            bf16x8 qf[2][2];
            float mx[2], sink[2];
#pragma unroll
            for (int e = 0; e < 2; ++e) {
                const int g = 2 * gp + e;
                float f0[8], f1[8];
                unpack8(qraw[g][0], f0);
                unpack8(qraw[g][1], f1);
                float ss = 0.f;
#pragma unroll
                for (int i = 0; i < 8; ++i) ss += f0[i] * f0[i] + f1[i] * f1[i];
                ss += shfl_xor_l(ss, 16, F.lane); ss += shfl_xor_l(ss, 32, F.lane);
                const float r = rsqrtf(ss * (1.f / SW_DH) + EPS) * 0.125f;
                u32x4 o0, o1;
                o0.x = pk2(f0[0] * r * ga0[0], f0[1] * r * ga0[1]); o0.y = pk2(f0[2] * r * ga0[2], f0[3] * r * ga0[3]); o0.z = pk2(f0[4] * r * ga1[0], f0[5] * r * ga1[1]); o0.w = pk2(f0[6] * r * ga1[2], f0[7] * r * ga1[3]);
                o1.x = pk2(f1[0] * r * gc0[0], f1[1] * r * gc0[1]); o1.y = pk2(f1[2] * r * gc0[2], f1[3] * r * gc0[3]); o1.z = pk2(f1[4] * r * gc1[0], f1[5] * r * gc1[1]); o1.w = pk2(f1[6] * r * gc1[2], f1[7] * r * gc1[3]);
                qf[e][0] = __builtin_bit_cast(bf16x8, o0); qf[e][1] = __builtin_bit_cast(bf16x8, o1);
                sink[e] = FIN(13)[j * SW_QH + hk * 4 + g]; mx[e] = sink[e];
            }
            f32x4 st[2][10];
#pragma unroll
            for (int half = 0; half < 2; ++half) {
                constexpr int NK0 = 5;
                const int kbase = half * NK0, nk = half ? 4 : 5;
                bf16x8 kf[5][2];
#pragma unroll
                for (int kk = 0; kk < 5; ++kk)
#pragma unroll
                    for (int ks = 0; ks < 2; ++ks) if (kk < nk) kf[kk][ks] = *(const LAS bf16x8*)(L + K_OFF + (16 * w + 16 * (kbase + kk) + fr) * RS + (32 * ks + 8 * fq) * 2);
                asm volatile("" ::: "memory"); __builtin_amdgcn_sched_barrier(0);
#pragma unroll
                for (int kk = 0; kk < 5; ++kk) if (kk < nk) {
#pragma unroll
                    for (int e = 0; e < 2; ++e) {
                        st[e][kbase + kk] = __builtin_amdgcn_mfma_f32_16x16x32_bf16(kf[kk][0], qf[e][0], (f32x4){0.f, 0.f, 0.f, 0.f}, 0, 0, 0);
                        st[e][kbase + kk] = __builtin_amdgcn_mfma_f32_16x16x32_bf16(kf[kk][1], qf[e][1], st[e][kbase + kk], 0, 0, 0); } }
                __builtin_amdgcn_sched_barrier(0);
            }
            float li[2];
#pragma unroll
            for (int e = 0; e < 2; ++e) {
#pragma unroll
                for (int r = 0; r < 4; ++r) { st[e][0][r] = (dq < r) ? st[e][0][r] : -INFINITY; st[e][8][r] = (dq >= r) ? st[e][8][r] : -INFINITY; }
                if (qb == 0) {
#pragma unroll
                    for (int kt = 0; kt < 9; ++kt)
#pragma unroll
                        for (int r = 0; r < 4; ++r) st[e][kt][r] = (16 * w + 16 * kt + 4 * fq + r >= 128) ? st[e][kt][r] : -INFINITY;
                }
#pragma unroll
                for (int kt = 0; kt < 9; ++kt)
#pragma unroll
                    for (int r = 0; r < 4; ++r) mx[e] = fmaxf(mx[e], st[e][kt][r]);
            }
#pragma unroll
            for (int e = 0; e < 2; ++e) mx[e] = fmaxf(mx[e], shfl_xor_l(mx[e], 16, F.lane));
#pragma unroll
            for (int e = 0; e < 2; ++e) mx[e] = fmaxf(mx[e], shfl_xor_l(mx[e], 32, F.lane));
            float l[2] = {0.f, 0.f};
#pragma unroll
            for (int e = 0; e < 2; ++e) {
#pragma unroll
                for (int kt = 0; kt < 9; ++kt)
#pragma unroll
                    for (int r = 0; r < 4; ++r) { const float p = __expf(st[e][kt][r] - mx[e]); st[e][kt][r] = p; l[e] += p; }
                st[e][9] = (f32x4){0.f, 0.f, 0.f, 0.f};
            }
#pragma unroll
            for (int e = 0; e < 2; ++e) l[e] += shfl_xor_l(l[e], 16, F.lane);
#pragma unroll
            for (int e = 0; e < 2; ++e) l[e] += shfl_xor_l(l[e], 32, F.lane);
#pragma unroll
            for (int e = 0; e < 2; ++e) li[e] = frcp(l[e] + __expf(sink[e] - mx[e]));
            f32x4 o[2][4];
#pragma unroll
            for (int e = 0; e < 2; ++e)
#pragma unroll
                for (int nt = 0; nt < 4; ++nt) o[e][nt] = (f32x4){0.f, 0.f, 0.f, 0.f};
#pragma unroll
            for (int kb = 0; kb < 5; ++kb) {
                bf16x8 pf[2];
#pragma unroll
                for (int e = 0; e < 2; ++e) { const f32x4 p0 = st[e][2 * kb] * li[e], p1 = st[e][2 * kb + 1] * li[e];
                    u32x4 pk; pk.x = pk2(p0[0], p0[1]); pk.y = pk2(p0[2], p0[3]); pk.z = pk2(p1[0], p1[1]); pk.w = pk2(p1[2], p1[3]);
                    pf[e] = __builtin_bit_cast(bf16x8, pk); }
                const LAS unsigned char* vb = L + V_OFF + (16 * w + 32 * kb + 4 * fq + (fr >> 2)) * RS + (16 * (fr & 3)) * 2;
                bf16x8 va[4];
#pragma unroll
                for (int nt = 0; nt < 4; ++nt) va[nt] = tr2(vb + 8 * nt, vb + 16 * RS + 8 * nt);
                asm volatile("" ::: "memory");
#pragma unroll
                for (int nt = 0; nt < 4; ++nt)
#pragma unroll
                    for (int e = 0; e < 2; ++e) o[e][nt] = __builtin_amdgcn_mfma_f32_16x16x32_bf16(va[nt], pf[e], o[e][nt], 0, 0, 0);
            }
#pragma unroll
            for (int e = 0; e < 2; ++e) {
                const int h = hk * 4 + 2 * gp + e;
                float hm = 0.f;
#pragma unroll
                for (int nt = 0; nt < 4; ++nt) hm = fmaxf(fmaxf(hm, fmaxf(fabsf(o[e][nt][0]), fabsf(o[e][nt][1]))), fmaxf(fabsf(o[e][nt][2]), fabsf(o[e][nt][3])));
                hm = fmaxf(hm, shfl_xor_l(hm, 16, F.lane)); hm = fmaxf(hm, shfl_xor_l(hm, 32, F.lane));
                const float sh = fmaxf(hm, 1e-30f), inv = 127.f * frcp(sh);
                if (fq == 0) hsc[h * 16 + fr] = sh;
                u32x4 q;
                q.x = pkq4(o[e][0][0] * inv, o[e][0][1] * inv, o[e][0][2] * inv, o[e][0][3] * inv); q.y = pkq4(o[e][1][0] * inv, o[e][1][1] * inv, o[e][1][2] * inv, o[e][1][3] * inv);
                q.z = pkq4(o[e][2][0] * inv, o[e][2][1] * inv, o[e][2][2] * inv, o[e][2][3] * inv); q.w = pkq4(o[e][3][0] * inv, o[e][3][1] * inv, o[e][3][2] * inv, o[e][3][3] * inv);
                *(GAS u32x4*)((GAS char*)WSP(unsigned char, WS_MIXQ) + (size_t)tq * D + h * SW_DH + 16 * fq) = q;
            }
        }
        if ((it & 3) == 3) mix_rescale<0>(F, tq, fr, fq, hsc);
        __syncthreads();
    }
}

__global__ void __launch_bounds__(NTHREADS, 2) mk_fwd(Args args) {
    extern __shared__ __attribute__((aligned(16))) unsigned char lds[];
    const int wave0 = __builtin_amdgcn_readfirstlane((int)threadIdx.x >> 6);
#define LEADER() (wave0 == 0 && lane_id_asm() == 0)
    volatile LAS unsigned* MISC = (volatile LAS unsigned*)((LAS unsigned char*)lds + MISC_OFF);
    if (threadIdx.x < 32) MISC[threadIdx.x] = 0u;
    __syncthreads();
    XcdBarrier bar; bar.bar = (gu32*)(args.ws + WS_CTL) + CW_BAR; bar.x = 0; bar.st = nullptr;
    if (!MK_PER_PHASE) bar = xcd_barrier_post((gu32*)(args.ws + WS_CTL) + CW_BAR, MISC + 8, LEADER());
    const int lo = args.ph_lo, hi = args.ph_hi;
    int ph = 0;
#define PHASE_BEGIN if (lo <= ph && ph < hi) { Frame F; frame_init(F, lds, wave0);
#define PHASE_END   if (ph + 1 < hi) { if (MK_PER_PHASE) { if (LEADER()) __hip_atomic_store((gu32*)(args.ws + WS_CTL) + CW_TMO, 0xBADBA0u, __ATOMIC_RELAXED, __HIP_MEMORY_SCOPE_AGENT); } else xcd_barrier(bar, LEADER()); } } ++ph;

    PHASE_BEGIN p0_prologue(F); PHASE_END
    PHASE_BEGIN p0b_modfinal(F); PHASE_END

    for (int layer = 0; layer < DEPTH; ++layer) {
        const int j = layer >> 1; const bool is_ml = (layer & 1) == 0;
        PHASE_BEGIN if (is_ml) normp_phase<1>(F, layer, 0, layer > 0); else normp_phase<0>(F, layer, 0, true); PHASE_END
        PHASE_BEGIN {
            const gbf16* Wt = (const gbf16*)(is_ml ? WSP(unsigned char, WS_WMLIN) + (size_t)j * ML_N * D : WSP(unsigned char, WS_WSWIN) + (size_t)j * SW_N * D);
            const int N = is_ml ? ML_N : SW_N;
            pg8::DenseOrder S; S.init(T, N, F.G, F.bid);
            pg8::EpiBf16Q E{WSP(bf16_t, WS_PROJ), N, is_ml ? 2 : 0, is_ml ? 4 : 0, 0.08838834764831845f, WSP(float, WS_SA), WSP(float, WS_SBIN) + (is_ml ? j * ML_N : 8192 + j * SW_N)};
            int Kq = D / 2; asm volatile("" : "+s"(Kq));
            pg8::gemm_phase<pg8::EpiBf16Q, pg8::DenseOrder, true, true>(F.lds, F.tid, WSP(bf16_t, WS_HNQ), Wt, Kq, S, E);
        } PHASE_END
        PHASE_BEGIN if (is_ml) ml_s1_mfma(F); else swa_mfma(F, j); PHASE_END
        if (is_ml) {
            PHASE_BEGIN ml_s2_phase(F); PHASE_END
            PHASE_BEGIN ml_s3_mfma(F, j); PHASE_END
        }
        PHASE_BEGIN {
            const gbf16* Wt = (const gbf16*)((is_ml ? WSP(unsigned char, WS_WMLOUT) : WSP(unsigned char, WS_WSWOUT)) + (size_t)j * D * D);
            pg8::DenseOrder S; S.init(T, D, F.G, F.bid);
            pg8::EpiResidQ E{WSP(bf16_t, WS_XB), WSP(float, WS_MOD) + (size_t)layer * 4 * 6144 + 2 * D, 6144, WSP(float, WS_SAM), WSP(float, WS_SBOUT) + (is_ml ? 0 : 2 * D) + j * D};
            int Kq = D / 2; asm volatile("" : "+s"(Kq));
            pg8::gemm_phase<pg8::EpiResidQ, pg8::DenseOrder, true, true>(F.lds, F.tid, WSP(bf16_t, WS_MIXQ), Wt, Kq, S, E);
        } PHASE_END
        PHASE_BEGIN normp_router(F, layer); PHASE_END
        PHASE_BEGIN {
            build_moe_tables(F, layer);
            const int nlab = (F.G % 8 == 0) ? 8 : 1;
            pg8::MoeOrder<3, true> S{(const LAS int*)(F.lds + TAB_BLK2E), (const LAS int*)(F.lds + TAB_BLKSTART), (const LAS int*)(F.lds + TAB_CNT), (const LAS int*)(F.lds + TAB_XBLK), WSP(unsigned, WS_LIST),
                                     ((const LAS int*)(F.lds + TAB_NBLK))[1] * 3, F.G / nlab, F.bid / nlab};
            pg8::EpiSwigluQ E{WSP(bf16_t, WS_H1), WSP(float, WS_SAE), WSP(float, WS_SB13) + (size_t)layer * NE * 768, (const LAS int*)(F.lds + TAB_BLK2E), (const LAS int*)(F.lds + TAB_BLKSTART)};
            int Kq = D / 2; asm volatile("" : "+s"(Kq));
            pg8::gemm_phase<pg8::EpiSwigluQ, pg8::MoeOrder<3, true>, true, true>(F.lds, F.tid, WSP(bf16_t, WS_HNQ), (const gbf16*)(WSP(unsigned char, WS_W13) + (size_t)layer * NE * 768 * D), Kq, S, E);
        } PHASE_END
        PHASE_BEGIN {
            build_moe_tables(F, layer);
            const int nlab = (F.G % 8 == 0) ? 8 : 1;
            pg8::MoeOrder<4, false> S{(const LAS int*)(F.lds + TAB_BLK2E), (const LAS int*)(F.lds + TAB_BLKSTART), (const LAS int*)(F.lds + TAB_CNT), (const LAS int*)(F.lds + TAB_XBLK), WSP(unsigned, WS_LIST),
                                      ((const LAS int*)(F.lds + TAB_NBLK))[1] * 4, F.G / nlab, F.bid / nlab};
            pg8::EpiYsQ E{WSP(unsigned char, WS_YS), WSP(float, WS_YSS)};
            int Kr = DE; asm volatile("" : "+s"(Kr));
            pg8::gemm_phase<pg8::EpiYsQ, pg8::MoeOrder<4, false>, true>(F.lds, F.tid, WSP(bf16_t, WS_H1), WSP(bf16_t, WS_W2) + (size_t)layer * NE * D * DE, Kr, S, E);
        } PHASE_END
    }
    PHASE_BEGIN final_phase(F); PHASE_END
#undef PHASE_BEGIN
#undef PHASE_END
}
constexpr int N_PHASES = 2 + (DEPTH / 2) * (9 + 7) + 1;

extern "C" void kernel_launch(void* const* d_in, const int* in_sizes, int n_in, void* d_out, int out_size, void* d_ws, size_t ws_size, hipStream_t stream) {
    static int grid = 0;
    if (grid == 0) {
        if (n_in != 22 || out_size != T * D || ws_size < WS_END) { fprintf(stderr, "kernel_launch: unexpected shapes (n_in %d, out %d, ws %zu < %zu); nothing launched\n", n_in, out_size, ws_size, (size_t)WS_END); grid = -1; return; }
        int dev = 0, cus = 0, per_cu = 0;
        if (hipGetDevice(&dev) != hipSuccess || hipDeviceGetAttribute(&cus, hipDeviceAttributeMultiprocessorCount, dev) != hipSuccess) { grid = -1; return; }
        if (hipFuncSetAttribute((const void*)mk_fwd, hipFuncAttributeMaxDynamicSharedMemorySize, LDS_BYTES) != hipSuccess) { fprintf(stderr, "kernel_launch: hipFuncSetAttribute failed\n"); grid = -1; return; }
        if (hipOccupancyMaxActiveBlocksPerMultiprocessor(&per_cu, (const void*)mk_fwd, NTHREADS, LDS_BYTES) != hipSuccess || per_cu < 1)
            fprintf(stderr, "kernel_launch: note: occupancy query reports %d workgroups per CU\n", per_cu);
        (void)hipGetLastError();
        grid = cus;
    }
    if (grid < 0) return;
    if (hipMemsetAsync((char*)d_ws + WS_CTL, 0, CTL_ZERO_BYTES, stream) != hipSuccess) { fprintf(stderr, "kernel_launch: memset failed\n"); return; }
    Args a{};
    for (int i = 0; i < 22; ++i) a.in[i] = (const float*)d_in[i];
    a.out = (float*)d_out; a.ws = (unsigned char*)d_ws;
#if MK_PER_PHASE
    for (int p = 0; p < N_PHASES; ++p) { a.ph_lo = p; a.ph_hi = p + 1; hipLaunchKernelGGL(mk_fwd, dim3(grid), dim3(NTHREADS), LDS_BYTES, stream, a); }
#else
    a.ph_lo = 0; a.ph_hi = N_PHASES;
    hipLaunchKernelGGL(mk_fwd, dim3(grid), dim3(NTHREADS), LDS_BYTES, stream, a);
#endif
    const hipError_t le = hipPeekAtLastError();
    if (le != hipSuccess) fprintf(stderr, "kernel_launch: launch failed: %s\n", hipGetErrorName(le));
}
```

```cpp
#include <hip/hip_runtime.h>
#include <cstdio>
#include <cstdint>

#define GAS __attribute__((address_space(1)))
#define LAS __attribute__((address_space(3)))
typedef unsigned short bf16_t;
typedef short bf16x8 __attribute__((ext_vector_type(8)));
typedef float f32x4 __attribute__((ext_vector_type(4)));
typedef int i32x4 __attribute__((ext_vector_type(4)));
typedef float f32x2 __attribute__((ext_vector_type(2)));
typedef unsigned u32x4 __attribute__((ext_vector_type(4)));
typedef unsigned u32x2 __attribute__((ext_vector_type(2)));
typedef GAS float gfloat; typedef GAS bf16_t gbf16; typedef GAS unsigned gu32; typedef GAS unsigned char gu8;

#ifndef MK_PER_PHASE
#define MK_PER_PHASE 0
#endif

constexpr int NBATCH = 4, SEQ = 8192, D = 1024, T = NBATCH * SEQ, DEPTH = 4;
constexpr int ML_H = 4, ML_DK = 128, ML_DV = 256, ML_N = 3072, ML_IN = 3080;
constexpr int LC = 128, NCH = SEQ / LC, ML_UNITS = NBATCH * ML_H * NCH;
constexpr int ST_ROWS = ML_DV + 1, ST_ELEMS = ST_ROWS * ML_DK;
constexpr int SW_QH = 16, SW_KVH = 4, SW_DH = 64, SW_N = 1536, WIN = 128;
constexpr int NE = 64, DE = 384, NRT = 80;
constexpr int CAP = 32768, MAXBLK = 320;
constexpr float EPS = 1e-6f, GATE_CAP = 15.0f;

constexpr size_t MiB = 1u << 20;
constexpr size_t WS_CTL = 0, CTL_ZERO_BYTES = 128 * 1024;
constexpr size_t WS_MOD = 1 * MiB;
constexpr size_t WS_MODP = 2 * MiB;
constexpr size_t WS_WRT = 8 * MiB;
constexpr size_t WS_WMLG = 9 * MiB;
constexpr size_t WS_IG = 10 * MiB, WS_LF = 11 * MiB;
constexpr size_t WS_CS = 12 * MiB;
constexpr size_t WS_TOKINFO = 13 * MiB, WS_TOKGATE = 14 * MiB;
constexpr size_t WS_WMLIN = 16 * MiB;
constexpr size_t WS_WMLOUT = 28 * MiB;
constexpr size_t WS_WSWIN = 32 * MiB;
constexpr size_t WS_WSWOUT = 38 * MiB;
constexpr size_t WS_LIST = 42 * MiB;
constexpr size_t WS_HN = 64 * MiB;
constexpr size_t WS_UST = 128 * MiB;
constexpr size_t WS_CST = 194 * MiB;
constexpr size_t WS_BIG = 260 * MiB;
constexpr size_t WS_PROJ = WS_BIG, WS_MIX = WS_BIG + 192 * MiB, WS_YS = WS_BIG, WS_H1 = WS_BIG + 160 * MiB;
constexpr size_t WS_W13 = 516 * MiB;
constexpr size_t WS_W2 = 900 * MiB;
constexpr size_t WS_XB = 1092 * MiB;
constexpr size_t WS_SA = 15 * MiB;
constexpr size_t WS_SBIN = 15 * MiB + 256 * 1024;
constexpr size_t WS_SAM = 15 * MiB + 512 * 1024;
constexpr size_t WS_SBOUT = 15 * MiB + 768 * 1024;
constexpr size_t WS_MIXQ = 64 * MiB;
constexpr size_t WS_YSS = WS_BIG + 96 * MiB;
constexpr size_t WS_CSX = 60 * MiB;
constexpr size_t WS_CSM = 15 * MiB + 800 * 1024;
constexpr size_t WS_SAE = 50 * MiB;
constexpr size_t WS_SB13 = 58 * MiB;
constexpr size_t WS_HNQ = WS_BIG + 220 * MiB;
constexpr size_t WS_END = 1156 * MiB;
constexpr int CW_TMO = 0, CW_BAR = 4096, CW_CNT = 16384;

constexpr int RING_BYTES = 131072;
constexpr int TAB_OFF = 141312;
constexpr int TAB_BLK2E = TAB_OFF, TAB_BLKSTART = TAB_OFF + 1280, TAB_CNT = TAB_OFF + 1600, TAB_NBLK = TAB_OFF + 1856, TAB_XBLK = TAB_OFF + 2048;
constexpr int MISC_OFF = TAB_OFF + 4096;
constexpr int LDS_BYTES = 147456;
constexpr int NWAVES = 8, NTHREADS = 512;

__device__ __forceinline__ float bf2f(unsigned h) { return __uint_as_float(h << 16); }
__device__ __forceinline__ unsigned f2bf(float f) { unsigned u = __float_as_uint(f); return (u + 0x7fffu + ((u >> 16) & 1u)) >> 16; }
typedef __bf16 bf16x2_t __attribute__((ext_vector_type(2)));
__device__ __forceinline__ unsigned pk2(float lo, float hi) { const f32x2 v = {lo, hi}; return __builtin_bit_cast(unsigned, __builtin_convertvector(v, bf16x2_t)); }
__device__ __forceinline__ unsigned pkq4(float x0, float x1, float x2, float x3) {
    const unsigned u0 = __float_as_uint(x0 + 12582912.f), u1 = __float_as_uint(x1 + 12582912.f), u2 = __float_as_uint(x2 + 12582912.f), u3 = __float_as_uint(x3 + 12582912.f);
    const unsigned t01 = __builtin_amdgcn_perm(u1, u0, 0x0c0c0400u), t23 = __builtin_amdgcn_perm(u3, u2, 0x0c0c0400u);
    return t01 | (t23 << 16);
}
__device__ __forceinline__ f32x4 unq4(unsigned w, float sc) {
    const int iw = (int)w;
    return (f32x4){(float)((iw << 24) >> 24), (float)((iw << 16) >> 24), (float)((iw << 8) >> 24), (float)(iw >> 24)} * sc;
}
__device__ __forceinline__ void st16_wt(GAS void* p, u32x4 v) { asm volatile("global_store_dwordx4 %0, %1, off sc1\n\ts_nop 1" :: "v"(p), "v"(v) : "memory"); }
typedef __bf16 bf2v_t __attribute__((ext_vector_type(2)));
__device__ __forceinline__ float dot2bf(unsigned a, unsigned b, float c) { return __builtin_amdgcn_fdot2_f32_bf16(__builtin_bit_cast(bf2v_t, a), __builtin_bit_cast(bf2v_t, b), c, false); }
__device__ __forceinline__ float shfl_up_l(float v, int o, int lane) { return __int_as_float(__builtin_amdgcn_ds_bpermute((lane - o) << 2, __float_as_int(v))); }
__device__ __forceinline__ float shfl_xor_l(float v, int o, int lane) { return __int_as_float(__builtin_amdgcn_ds_bpermute((lane ^ o) << 2, __float_as_int(v))); }
__device__ __forceinline__ float wave_sum(float v, int lane) {
#pragma unroll
    for (int o = 1; o < 64; o <<= 1) v += shfl_xor_l(v, o, lane);
    return v;
}
__device__ __forceinline__ float frcp(float x) { return __builtin_amdgcn_rcpf(x); }
__device__ __forceinline__ float sigmoidf_(float x) { return frcp(1.f + __expf(-x)); }
__device__ __forceinline__ void unpack8(u32x4 w, float (&o)[8]) {
    o[0] = bf2f(w.x & 0xffffu); o[1] = bf2f(w.x >> 16); o[2] = bf2f(w.y & 0xffffu); o[3] = bf2f(w.y >> 16);
    o[4] = bf2f(w.z & 0xffffu); o[5] = bf2f(w.z >> 16); o[6] = bf2f(w.w & 0xffffu); o[7] = bf2f(w.w >> 16);
}

__device__ __forceinline__ int lane_id_asm() { int ln; asm volatile("v_mbcnt_lo_u32_b32 %0, -1, 0\n\tv_mbcnt_hi_u32_b32 %0, -1, %0" : "=v"(ln)); return ln; }
namespace pg8 {
constexpr int BM = 256, BK = 64, HALF = 128, HTB = HALF * BK * 2, STAGE_BYTES = 8 * HTB, NXCD = 8, WGM = 8;
constexpr int SCL_REL = STAGE_BYTES;
__host__ __device__ __forceinline__ int lds_byte(int r, int c) { const int st = (r >> 4) * 2 + (c >> 5), rr = r & 15, cc = c & 31, ob = rr * 64 + cc * 2; return st * 1024 + (ob ^ (((ob >> 9) & 1) << 5)); }
__host__ __device__ __forceinline__ void stage_rc(int b, int& R, int& C) { const int st = b / 1024, sb = b % 1024, swz = sb ^ (((sb >> 9) & 1) << 5); R = (st >> 1) * 16 + swz / 64; C = (st & 1) * 32 + (swz % 64) / 2; }
__host__ __device__ __forceinline__ int perm32(int rho) { const int n = rho >> 4, i = rho & 15; return 8 * (i >> 2) + 4 * n + (i & 3); }
__device__ __forceinline__ unsigned cvt_pk_bf16(float lo, float hi) { unsigned r; asm volatile("v_cvt_pk_bf16_f32 %0, %1, %2" : "=v"(r) : "v"(lo), "v"(hi)); return r; }

struct Unit { int pm, pn, pb; };

struct DenseOrder {
    static constexpr bool GATHER = false;
    int nM, nN, nwg, G, c;
    __device__ void init(int M, int N, int G_, int c_) { nM = M / BM; nN = N / BM; nwg = nM * nN; G = G_; c = c_; }
    __device__ __forceinline__ bool next(int i, Unit& u) const {
        const long L = (long)i * G + c; if (L >= nwg) return false;
        int wgid = (int)L; { const int q = nwg / NXCD, r = nwg % NXCD, xcd = wgid % NXCD, off = wgid / NXCD; wgid = (xcd < r ? xcd * (q + 1) : r * (q + 1) + (xcd - r) * q) + off; }
        const int nig = WGM * nN, gid = wgid / nig, fm = gid * WGM, gsz = (nM - fm) < WGM ? (nM - fm) : WGM;
        u.pm = fm + ((wgid % nig) % gsz); u.pn = (wgid % nig) / gsz; u.pb = u.pn; return true;
    }
    __device__ __forceinline__ unsigned a_row(const Unit& u, int h, int R) const { return (unsigned)(u.pm * BM + h * HALF + R); }
};
template <int NT, bool GATHER_> struct MoeOrder {
    static constexpr bool GATHER = GATHER_;
    const LAS int* blk2e; const LAS int* blkstart; const LAS int* cnt; const LAS int* xblk; const gu32* list; int nunits, W, r;
    __device__ __forceinline__ bool next(int i, Unit& u) const {
        const int L = i * W + r; if (L >= nunits) return false;
        const int bi = L / NT, nt = L - bi * NT, blk = xblk[bi], e = blk2e[blk];
        u.pm = blk; u.pn = nt; u.pb = e * NT + nt; return true;
    }
    __device__ __forceinline__ unsigned a_row(const Unit& u, int h, int R) const {
        if (!GATHER_) return (unsigned)(u.pm * BM + h * HALF + R);
        const int e = blk2e[u.pm]; const int rank = (u.pm - blkstart[e]) * BM + h * HALF + R;
        return rank < cnt[e] ? list[(size_t)e * CAP + rank] : 0u;
    }
};

struct EpiBf16 {
    static constexpr bool PERM = true; static constexpr int NSTORES = 16;
    gbf16* O; int ldc; int ks_lo, ks_hi; float kscale;
    __device__ __forceinline__ void operator()(const f32x4 (&acc)[2][2][4][2], const Unit& u, int wr, int wc, int fr, int fq) const {
        const float sc = (u.pn >= ks_lo && u.pn < ks_hi) ? kscale : 1.f;
        const int row0 = u.pm * BM + wr * 64 + fr, col0 = u.pn * BM + wc * 32 + 8 * fq;
#pragma unroll
        for (int ai = 0; ai < 2; ++ai)
#pragma unroll
            for (int m = 0; m < 4; ++m) { gbf16* rowp = O + (size_t)(row0 + ai * HALF + m * 16) * ldc + col0;
#pragma unroll
                for (int bj = 0; bj < 2; ++bj) { const f32x4 v0 = acc[ai][bj][m][0] * sc, v1 = acc[ai][bj][m][1] * sc;
                    u32x4 w; w.x = cvt_pk_bf16(v0[0], v0[1]); w.y = cvt_pk_bf16(v0[2], v0[3]); w.z = cvt_pk_bf16(v1[0], v1[1]); w.w = cvt_pk_bf16(v1[2], v1[3]);
                    *(GAS u32x4*)(rowp + bj * HALF) = w; } }
    }
};
struct EpiBf16Q {
    static constexpr bool PERM = true; static constexpr int NSTORES = 16;
    gbf16* O; int ldc; int ks_lo, ks_hi; float kscale; const gfloat* sa; const gfloat* sb;
    __device__ __forceinline__ void pre(const Unit& u, int wid, LAS float* buf) const {
        const int ln = lane_id_asm();
        const gfloat* src = (wid < 4) ? sa + (size_t)u.pm * BM + 64 * wid + ln : sb + (size_t)u.pn * BM + 64 * (wid - 4) + ln;
        __builtin_amdgcn_global_load_lds((const GAS unsigned*)src, (LAS unsigned*)(buf + 64 * wid), 4, 0, 0);
    }
    __device__ __forceinline__ void operator()(const f32x4 (&acc)[2][2][4][2], const Unit& u, int wr, int wc, int fr, int fq, const LAS float* buf) const {
        const float sc = (u.pn >= ks_lo && u.pn < ks_hi) ? kscale : 1.f;
        const int row0 = u.pm * BM + wr * 64 + fr, col0 = u.pn * BM + wc * 32 + 8 * fq;
        f32x4 sbv[2][2]; float sav[2][4];
#pragma unroll
        for (int bj = 0; bj < 2; ++bj)
#pragma unroll
            for (int n = 0; n < 2; ++n) sbv[bj][n] = *(const LAS f32x4*)(buf + 256 + wc * 32 + 8 * fq + bj * HALF + 4 * n);
#pragma unroll
        for (int ai = 0; ai < 2; ++ai)
#pragma unroll
            for (int m = 0; m < 4; ++m) sav[ai][m] = buf[wr * 64 + fr + ai * HALF + m * 16];
#pragma unroll
        for (int ai = 0; ai < 2; ++ai)
#pragma unroll
            for (int m = 0; m < 4; ++m) { gbf16* rowp = O + (size_t)(row0 + ai * HALF + m * 16) * ldc + col0; const float rs = sav[ai][m] * sc;
#pragma unroll
                for (int bj = 0; bj < 2; ++bj) {
                    const f32x4 v0 = __builtin_convertvector(__builtin_bit_cast(i32x4, acc[ai][bj][m][0]), f32x4) * sbv[bj][0] * rs;
                    const f32x4 v1 = __builtin_convertvector(__builtin_bit_cast(i32x4, acc[ai][bj][m][1]), f32x4) * sbv[bj][1] * rs;
                    u32x4 w; w.x = cvt_pk_bf16(v0[0], v0[1]); w.y = cvt_pk_bf16(v0[2], v0[3]); w.z = cvt_pk_bf16(v1[0], v1[1]); w.w = cvt_pk_bf16(v1[2], v1[3]);
                    st16_wt(rowp + bj * HALF, w); } }
    }
};
struct EpiYsQ {
    static constexpr bool PERM = true; static constexpr int NSTORES = 16;
    gu8* Y; gfloat* YSc;
    __device__ __forceinline__ void operator()(const f32x4 (&acc)[2][2][4][2], const Unit& u, int wr, int wc, int fr, int fq) const {
        const int lane = fr + 16 * fq;
        const int row0 = u.pm * BM + wr * 64 + fr, colw = u.pn * BM + wc * 32;
        float mx[2][4][2];
#pragma unroll
        for (int ai = 0; ai < 2; ++ai)
#pragma unroll
            for (int m = 0; m < 4; ++m)
#pragma unroll
                for (int bj = 0; bj < 2; ++bj) { const f32x4 a = acc[ai][bj][m][0], b = acc[ai][bj][m][1];
                    mx[ai][m][bj] = fmaxf(fmaxf(fmaxf(fabsf(a[0]), fabsf(a[1])), fmaxf(fabsf(a[2]), fabsf(a[3]))), fmaxf(fmaxf(fabsf(b[0]), fabsf(b[1])), fmaxf(fabsf(b[2]), fabsf(b[3])))); }
#pragma unroll
        for (int o = 16; o < 64; o <<= 1)
#pragma unroll
            for (int ai = 0; ai < 2; ++ai)
#pragma unroll
                for (int m = 0; m < 4; ++m)
#pragma unroll
                    for (int bj = 0; bj < 2; ++bj) mx[ai][m][bj] = fmaxf(mx[ai][m][bj], shfl_xor_l(mx[ai][m][bj], o, lane));
#pragma unroll
        for (int ai = 0; ai < 2; ++ai)
#pragma unroll
            for (int m = 0; m < 4; ++m) { const size_t row = (size_t)(row0 + ai * HALF + m * 16);
#pragma unroll
                for (int bj = 0; bj < 2; ++bj) { const float m_ = fmaxf(mx[ai][m][bj], 1e-30f), inv = 127.f * __builtin_amdgcn_rcpf(m_);
                    const f32x4 a = acc[ai][bj][m][0] * inv, b = acc[ai][bj][m][1] * inv;
                    u32x2 q; q.x = pkq4(a[0], a[1], a[2], a[3]); q.y = pkq4(b[0], b[1], b[2], b[3]);
                    *(GAS u32x2*)(Y + row * D + colw + bj * HALF + 8 * fq) = q;
                    if (fq == 0) YSc[row * 32 + ((colw + bj * HALF) >> 5)] = m_ * (1.f / 127.f); } }
    }
};
struct EpiResid {
    static constexpr bool PERM = true; static constexpr int NSTORES = 16;
    gbf16* X; const gfloat* gate; int gate_bstride;
    __device__ __forceinline__ void operator()(const f32x4 (&acc)[2][2][4][2], const Unit& u, int wr, int wc, int fr, int fq) const {
        const int b = (u.pm * BM) / SEQ; const gfloat* gp = gate + (size_t)b * gate_bstride;
        const int row0 = u.pm * BM + wr * 64 + fr, col0 = u.pn * BM + wc * 32 + 8 * fq;
        f32x4 gv[2][2];
#pragma unroll
        for (int bj = 0; bj < 2; ++bj)
#pragma unroll
            for (int n = 0; n < 2; ++n) gv[bj][n] = *(const GAS f32x4*)(gp + col0 + bj * HALF + 4 * n);
#pragma unroll
        for (int ai = 0; ai < 2; ++ai) {
            u32x4 xr[4][2];
#pragma unroll
            for (int m = 0; m < 4; ++m)
#pragma unroll
                for (int bj = 0; bj < 2; ++bj) xr[m][bj] = *(const GAS u32x4*)(X + (size_t)(row0 + ai * HALF + m * 16) * D + col0 + bj * HALF);
            asm volatile("" ::: "memory");
#pragma unroll
            for (int m = 0; m < 4; ++m)
#pragma unroll
                for (int bj = 0; bj < 2; ++bj) { float x[8]; unpack8(xr[m][bj], x);
                    const f32x4 v0 = acc[ai][bj][m][0] * gv[bj][0], v1 = acc[ai][bj][m][1] * gv[bj][1];
                    u32x4 w; w.x = cvt_pk_bf16(x[0] + v0[0], x[1] + v0[1]); w.y = cvt_pk_bf16(x[2] + v0[2], x[3] + v0[3]); w.z = cvt_pk_bf16(x[4] + v1[0], x[5] + v1[1]); w.w = cvt_pk_bf16(x[6] + v1[2], x[7] + v1[3]);
                    *(GAS u32x4*)(X + (size_t)(row0 + ai * HALF + m * 16) * D + col0 + bj * HALF) = w; }
        }
    }
};
struct EpiResidQ {
    static constexpr bool PERM = true; static constexpr int NSTORES = 16;
    gbf16* X; const gfloat* gate; int gate_bstride; const gfloat* sa; const gfloat* sb;
    __device__ __forceinline__ void pre(const Unit& u, int wid, LAS float* buf) const {
        const int ln = lane_id_asm();
        const gfloat* src = (wid < 4) ? sa + (size_t)u.pm * BM + 64 * wid + ln : sb + (size_t)u.pn * BM + 64 * (wid - 4) + ln;
        __builtin_amdgcn_global_load_lds((const GAS unsigned*)src, (LAS unsigned*)(buf + 64 * wid), 4, 0, 0);
    }
    __device__ __forceinline__ void operator()(const f32x4 (&acc)[2][2][4][2], const Unit& u, int wr, int wc, int fr, int fq, const LAS float* buf) const {
        const int b = (u.pm * BM) / SEQ; const gfloat* gp = gate + (size_t)b * gate_bstride;
        const int row0 = u.pm * BM + wr * 64 + fr, col0 = u.pn * BM + wc * 32 + 8 * fq;
        f32x4 gv[2][2];
#pragma unroll
        for (int bj = 0; bj < 2; ++bj)
#pragma unroll
            for (int n = 0; n < 2; ++n) gv[bj][n] = *(const GAS f32x4*)(gp + col0 + bj * HALF + 4 * n) * *(const LAS f32x4*)(buf + 256 + wc * 32 + 8 * fq + bj * HALF + 4 * n);
#pragma unroll
        for (int ai = 0; ai < 2; ++ai) {
            u32x4 xr[4][2]; float sav[4];
#pragma unroll
            for (int m = 0; m < 4; ++m)
#pragma unroll
                for (int bj = 0; bj < 2; ++bj) xr[m][bj] = *(const GAS u32x4*)(X + (size_t)(row0 + ai * HALF + m * 16) * D + col0 + bj * HALF);
#pragma unroll
            for (int m = 0; m < 4; ++m) sav[m] = buf[wr * 64 + fr + ai * HALF + m * 16];
            asm volatile("" ::: "memory");
#pragma unroll
            for (int m = 0; m < 4; ++m)
#pragma unroll
                for (int bj = 0; bj < 2; ++bj) { float x[8]; unpack8(xr[m][bj], x);
                    const f32x4 v0 = __builtin_convertvector(__builtin_bit_cast(i32x4, acc[ai][bj][m][0]), f32x4) * gv[bj][0] * sav[m];
                    const f32x4 v1 = __builtin_convertvector(__builtin_bit_cast(i32x4, acc[ai][bj][m][1]), f32x4) * gv[bj][1] * sav[m];
                    u32x4 w; w.x = cvt_pk_bf16(x[0] + v0[0], x[1] + v0[1]); w.y = cvt_pk_bf16(x[2] + v0[2], x[3] + v0[3]); w.z = cvt_pk_bf16(x[4] + v1[0], x[5] + v1[1]); w.w = cvt_pk_bf16(x[6] + v1[2], x[7] + v1[3]);
                    *(GAS u32x4*)(X + (size_t)(row0 + ai * HALF + m * 16) * D + col0 + bj * HALF) = w; }
        }
    }
};
struct EpiSwiglu {
    static constexpr bool PERM = true; static constexpr int NSTORES = 8;
    gbf16* H;
    __device__ __forceinline__ void operator()(const f32x4 (&acc)[2][2][4][2], const Unit& u, int wr, int wc, int fr, int fq) const {
        const int row0 = u.pm * BM + wr * 64 + fr, col0 = u.pn * HALF + wc * 32 + 8 * fq;
#pragma unroll
        for (int ai = 0; ai < 2; ++ai)
#pragma unroll
            for (int m = 0; m < 4; ++m) { gbf16* rowp = H + (size_t)(row0 + ai * HALF + m * 16) * DE + col0;
                float o[8];
#pragma unroll
                for (int n = 0; n < 2; ++n)
#pragma unroll
                    for (int j = 0; j < 4; ++j) { const float a = acc[ai][0][m][n][j], b = acc[ai][1][m][n][j]; o[4 * n + j] = a * __builtin_amdgcn_rcpf(1.f + __expf(-a)) * b; }
                u32x4 w; w.x = cvt_pk_bf16(o[0], o[1]); w.y = cvt_pk_bf16(o[2], o[3]); w.z = cvt_pk_bf16(o[4], o[5]); w.w = cvt_pk_bf16(o[6], o[7]);
                *(GAS u32x4*)rowp = w; }
    }
};

struct EpiSwigluQ {
    static constexpr bool PERM = true; static constexpr int NSTORES = 8;
    gbf16* H; const gfloat* sae; const gfloat* sb; const LAS int* blk2e; const LAS int* blkstart;
    __device__ __forceinline__ void pre(const Unit& u, int wid, LAS float* buf) const {
        const int ln = lane_id_asm();
        const int e = blk2e[u.pm];
        const gfloat* src = (wid < 4) ? sae + (size_t)e * CAP + (u.pm - blkstart[e]) * BM + 64 * wid + ln : sb + (size_t)u.pb * BM + 64 * (wid - 4) + ln;
        __builtin_amdgcn_global_load_lds((const GAS unsigned*)src, (LAS unsigned*)(buf + 64 * wid), 4, 0, 0);
    }
    __device__ __forceinline__ void operator()(const f32x4 (&acc)[2][2][4][2], const Unit& u, int wr, int wc, int fr, int fq, const LAS float* buf) const {
        const int row0 = u.pm * BM + wr * 64 + fr, col0 = u.pn * HALF + wc * 32 + 8 * fq;
        f32x4 sbv[2][2]; float sav[2][4];
#pragma unroll
        for (int bj = 0; bj < 2; ++bj)
#pragma unroll
            for (int n = 0; n < 2; ++n) sbv[bj][n] = *(const LAS f32x4*)(buf + 256 + wc * 32 + 8 * fq + bj * HALF + 4 * n);
#pragma unroll
        for (int ai = 0; ai < 2; ++ai)
#pragma unroll
            for (int m = 0; m < 4; ++m) sav[ai][m] = buf[wr * 64 + fr + ai * HALF + m * 16];
#pragma unroll
        for (int ai = 0; ai < 2; ++ai)
#pragma unroll
            for (int m = 0; m < 4; ++m) { gbf16* rowp = H + (size_t)(row0 + ai * HALF + m * 16) * DE + col0;
                float o[8];
#pragma unroll
                for (int n = 0; n < 2; ++n) {
                    const f32x4 av = __builtin_convertvector(__builtin_bit_cast(i32x4, acc[ai][0][m][n]), f32x4) * sbv[0][n] * sav[ai][m];
                    const f32x4 bv = __builtin_convertvector(__builtin_bit_cast(i32x4, acc[ai][1][m][n]), f32x4) * sbv[1][n] * sav[ai][m];
#pragma unroll
                    for (int j = 0; j < 4; ++j) o[4 * n + j] = av[j] * __builtin_amdgcn_rcpf(1.f + __expf(-av[j])) * bv[j]; }
                u32x4 w; w.x = cvt_pk_bf16(o[0], o[1]); w.y = cvt_pk_bf16(o[2], o[3]); w.z = cvt_pk_bf16(o[4], o[5]); w.w = cvt_pk_bf16(o[6], o[7]);
                *(GAS u32x4*)rowp = w; }
    }
};

template <class Epi, class Sched, bool ALIGN_EPI, bool I8 = false>
__device__ __forceinline__ void gemm_phase(LAS unsigned char* lds, const int tid, const gbf16* A, const gbf16* Bt, int K, const Sched& S, const Epi& E) {
    const int wid = __builtin_amdgcn_readfirstlane(tid >> 6), lane = tid & 63, wr = wid >> 2, wc = wid & 3, fr = lane & 15, fq = lane >> 4;
    const int nt = K / BK;
    int Rr[2], Cc[2]; unsigned voffB[2];
#pragma unroll
    for (int i = 0; i < 2; ++i) { stage_rc(tid * 16 + i * 8192, Rr[i], Cc[i]); const int Rb = Epi::PERM ? ((Rr[i] & ~31) + perm32(Rr[i] & 31)) : Rr[i]; voffB[i] = (unsigned)(Rb * K + Cc[i]) * 2u; }
    const size_t kstep = (size_t)(BK * 2);
    const size_t hstep = (size_t)HALF * K * 2;
    const size_t tstep = 2 * hstep;
    const unsigned ldsw = (unsigned)wid * 1024u;
    const int aoff = lds_byte(wr * 64 + fr, fq * 8), boff = lds_byte(wc * 32 + fr, fq * 8);
#define PG8_SA(b, h) (((b) * 2 + (h)) * HTB)
#define PG8_SB(b, h) ((4 + (b) * 2 + (h)) * HTB)
#define PG8_STAGE(bufoff, gbase, voff) do { _Pragma("unroll") for (int _i = 0; _i < 2; ++_i) \
        __builtin_amdgcn_global_load_lds((const GAS unsigned*)((const GAS char*)(gbase) + (voff)[_i]), (LAS unsigned*)(lds + (bufoff) + ldsw + _i * 8192), 16, 0, 0); } while (0)
#define PG8_LDA(dst, b, h) do { _Pragma("unroll") for (int m = 0; m < 4; ++m) _Pragma("unroll") for (int k = 0; k < 2; ++k) dst[m][k] = *(const LAS bf16x8*)(lds + PG8_SA(b, h) + aoff + m * 2048 + k * 1024); } while (0)
#define PG8_LDB(dst, b, h) do { _Pragma("unroll") for (int n = 0; n < 2; ++n) _Pragma("unroll") for (int k = 0; k < 2; ++k) dst[n][k] = *(const LAS bf16x8*)(lds + PG8_SB(b, h) + boff + n * 2048 + k * 1024); } while (0)
#define PG8_MMA(ai, bj, At, Bt_) do { __builtin_amdgcn_s_setprio(1); _Pragma("unroll") for (int m = 0; m < 4; ++m) _Pragma("unroll") for (int n = 0; n < 2; ++n) _Pragma("unroll") for (int k = 0; k < 2; ++k) \
        { if constexpr (I8) acc[ai][bj][m][n] = __builtin_bit_cast(f32x4, __builtin_amdgcn_mfma_i32_16x16x64_i8(__builtin_bit_cast(i32x4, Bt_[n][k]), __builtin_bit_cast(i32x4, At[m][k]), __builtin_bit_cast(i32x4, acc[ai][bj][m][n]), 0, 0, 0)); \
          else acc[ai][bj][m][n] = __builtin_amdgcn_mfma_f32_16x16x32_bf16(Bt_[n][k], At[m][k], acc[ai][bj][m][n], 0, 0, 0); } __builtin_amdgcn_s_setprio(0); } while (0)
#define PG8_WAIT_V(n) asm volatile("s_waitcnt vmcnt(" #n ")" ::: "memory")
#define PG8_WAIT_RELAX(flag) do { if constexpr (Epi::NSTORES == 16) asm volatile("s_cmp_lg_u32 %0, 0\n\ts_cbranch_scc1 1f\n\ts_waitcnt vmcnt(8)\n\ts_branch 2f\n1:\n\ts_waitcnt vmcnt(24)\n2:" :: "s"(flag) : "memory", "scc"); \
        else { static_assert(Epi::NSTORES == 8 || Epi::NSTORES == 16, "NSTORES"); asm volatile("s_cmp_lg_u32 %0, 0\n\ts_cbranch_scc1 1f\n\ts_waitcnt vmcnt(8)\n\ts_branch 2f\n1:\n\ts_waitcnt vmcnt(16)\n2:" :: "s"(flag) : "memory", "scc"); } } while (0)
#define PG8_WAIT_L(n) asm volatile("s_waitcnt lgkmcnt(" #n ")" ::: "memory")
#define PG8_BAR __builtin_amdgcn_s_barrier()
#define PG8_SCHED __builtin_amdgcn_sched_barrier(0)
    Unit cur, nxt; int ui = 0;
    if (!S.next(0, cur)) return;
    LAS float* const scl = (LAS float*)(lds + SCL_REL);
    f32x4 acc[2][2][4][2];
#pragma unroll
    for (int a = 0; a < 2; ++a)
#pragma unroll
        for (int b = 0; b < 2; ++b)
#pragma unroll
            for (int m = 0; m < 4; ++m)
#pragma unroll
                for (int n = 0; n < 2; ++n) acc[a][b][m][n] = (f32x4){0.f, 0.f, 0.f, 0.f};
    bf16x8 At[4][2], B0[2][2], B1[2][2];
    unsigned vo[2][2], nvo[2][2], voffA[2];
    const GAS char* Ab = (const GAS char*)A;
    const GAS char* cA = Ab; const GAS char* nA = Ab;
    if constexpr (Sched::GATHER) {
#pragma unroll
        for (int h = 0; h < 2; ++h)
#pragma unroll
            for (int i = 0; i < 2; ++i) vo[h][i] = (S.a_row(cur, h, Rr[i]) * (unsigned)K + (unsigned)Cc[i]) * 2u;
    } else {
#pragma unroll
        for (int i = 0; i < 2; ++i) voffA[i] = (unsigned)(Rr[i] * K + Cc[i]) * 2u;
        cA = Ab + (size_t)cur.pm * tstep;
    }
#define PG8_STAGE_A(bufoff, kb, h, NEXT) do { if constexpr (Sched::GATHER) { const unsigned _vv[2] = {(NEXT) ? nvo[h][0] : vo[h][0], (NEXT) ? nvo[h][1] : vo[h][1]}; PG8_STAGE(bufoff, Ab + (kb), _vv); } \
        else { PG8_STAGE(bufoff, ((NEXT) ? nA : cA) + (size_t)(h) * hstep + (kb), voffA); } } while (0)
    const GAS char* cB = (const GAS char*)Bt + (size_t)cur.pb * tstep;
    PG8_STAGE(PG8_SB(0, 0), cB, voffB); PG8_STAGE(PG8_SB(0, 1), cB + hstep, voffB); PG8_STAGE_A(PG8_SA(0, 0), (size_t)0, 0, false); PG8_STAGE_A(PG8_SA(0, 1), (size_t)0, 1, false);
    if (wr == 1) PG8_BAR;
    PG8_WAIT_V(2); PG8_BAR;
    PG8_STAGE(PG8_SB(1, 0), cB + kstep, voffB); PG8_STAGE_A(PG8_SA(1, 0), kstep, 0, false); PG8_STAGE(PG8_SB(1, 1), cB + hstep + kstep, voffB);
    PG8_WAIT_V(6); PG8_BAR;
    for (;;) {
        const bool has_next = S.next(ui + 1, nxt);
        if constexpr (Sched::GATHER) {
#pragma unroll
            for (int h = 0; h < 2; ++h)
#pragma unroll
                for (int i = 0; i < 2; ++i) nvo[h][i] = has_next ? (S.a_row(nxt, h, Rr[i]) * (unsigned)K + (unsigned)Cc[i]) * 2u : vo[h][i];
        } else nA = has_next ? Ab + (size_t)nxt.pm * tstep : cA;
        const GAS char* nB = has_next ? (const GAS char*)Bt + (size_t)nxt.pb * tstep : cB;
        if constexpr (I8) E.pre(cur, wid, scl + (ui & 1) * 512);
        for (int t = 0; t < nt; t += 2) {
            const bool last = (t == nt - 2);
            const size_t k1 = (size_t)(t + 1) * kstep, k2 = last ? (size_t)0 : (size_t)(t + 2) * kstep, k3 = k2 + kstep;
            const GAS char* b2 = last ? nB : cB + (size_t)(t + 2) * kstep; const GAS char* b3 = b2 + kstep;
            const int relax = __builtin_amdgcn_readfirstlane(((ui > 0) && (t == 0)) ? 1 : 0);
            PG8_LDB(B0, 0, 0); PG8_LDB(B1, 0, 1); PG8_SCHED; PG8_LDA(At, 0, 0); PG8_STAGE_A(PG8_SA(1, 1), k1, 1, false);
            PG8_WAIT_RELAX(relax);
            PG8_WAIT_L(0); PG8_BAR; PG8_MMA(0, 0, At, B0); PG8_MMA(0, 1, At, B1); PG8_BAR; PG8_SCHED;
            PG8_LDA(At, 0, 1); PG8_STAGE(PG8_SB(0, 0), b2, voffB); PG8_STAGE(PG8_SB(0, 1), b2 + hstep, voffB); PG8_STAGE_A(PG8_SA(0, 0), k2, 0, last);
            PG8_WAIT_RELAX(relax);
            PG8_WAIT_L(0); PG8_BAR; PG8_MMA(1, 0, At, B0); PG8_MMA(1, 1, At, B1); PG8_BAR; PG8_SCHED;
            PG8_LDB(B0, 1, 0); PG8_LDB(B1, 1, 1); PG8_SCHED; PG8_LDA(At, 1, 0); PG8_STAGE_A(PG8_SA(0, 1), k2, 1, last);
            PG8_WAIT_V(8); PG8_WAIT_L(0); PG8_BAR; PG8_MMA(0, 0, At, B0); PG8_MMA(0, 1, At, B1); PG8_BAR; PG8_SCHED;
            PG8_LDA(At, 1, 1); PG8_STAGE(PG8_SB(1, 0), b3, voffB); PG8_STAGE(PG8_SB(1, 1), b3 + hstep, voffB); PG8_STAGE_A(PG8_SA(1, 0), k3, 0, last);
            PG8_WAIT_V(8); PG8_WAIT_L(0); PG8_BAR; PG8_MMA(1, 0, At, B0); PG8_MMA(1, 1, At, B1); PG8_BAR; PG8_SCHED;
        }
        if constexpr (ALIGN_EPI) { if (wr == 0) PG8_BAR; }
        { const int le = lane_id_asm(); if constexpr (I8) E(acc, cur, wr, wc, le & 15, le >> 4, scl + (ui & 1) * 512); else E(acc, cur, wr, wc, le & 15, le >> 4); }
        if (!has_next) break;
#pragma unroll
        for (int a = 0; a < 2; ++a)
#pragma unroll
            for (int b = 0; b < 2; ++b)
#pragma unroll
                for (int m = 0; m < 4; ++m)
#pragma unroll
                    for (int n = 0; n < 2; ++n) acc[a][b][m][n] = (f32x4){0.f, 0.f, 0.f, 0.f};
        cur = nxt; cB = nB; ++ui;
        if constexpr (Sched::GATHER) {
#pragma unroll
            for (int h = 0; h < 2; ++h)
#pragma unroll
                for (int i = 0; i < 2; ++i) vo[h][i] = nvo[h][i];
        } else cA = nA;
        if constexpr (ALIGN_EPI) { if (wr == 1) PG8_BAR; }
    }
    PG8_WAIT_V(0);
    if constexpr (!ALIGN_EPI) { if (wr == 0) PG8_BAR; }
    PG8_BAR;
#undef PG8_SA
#undef PG8_SB
#undef PG8_STAGE
#undef PG8_STAGE_A
#undef PG8_LDA
#undef PG8_LDB
#undef PG8_MMA
#undef PG8_WAIT_V
#undef PG8_WAIT_L
#undef PG8_WAIT_RELAX
#undef PG8_BAR
#undef PG8_SCHED
}
}

#define XB_TMO      128
#define XB_XCNT(j)  (256  + 64 * (j))
#define XB_XSUB(j)  (1280 + 64 * (j))
#define XB_XGEN(j)  (2304 + 64 * (j))
#define XB_TOP      3328
#define XB_TOPGEN   3392
#define XCD_BAR_WORDS 3456
#define XB_SPIN_CAP (1u << 18)
__device__ __forceinline__ unsigned xb_ld(gu32* p)              { return __hip_atomic_load(p, __ATOMIC_RELAXED, __HIP_MEMORY_SCOPE_AGENT); }
__device__ __forceinline__ unsigned xb_add(gu32* p, unsigned v) { return __hip_atomic_fetch_add(p, v, __ATOMIC_RELAXED, __HIP_MEMORY_SCOPE_AGENT); }
__device__ __forceinline__ unsigned xb_xcc_id() { return (unsigned)__builtin_amdgcn_s_getreg((3 << 11) | 20) & 0xFu; }
#define XB_SPIN(cond, bar) do { unsigned _sp = 0; while (cond) { __builtin_amdgcn_s_sleep(1); \
    if ((++_sp & 255u) == 0u) { if (xb_ld(&(bar)[XB_TMO])) break; if (_sp > XB_SPIN_CAP) { (void)xb_add(&(bar)[XB_TMO], 1u); break; } } } } while (0)
struct XcdBarrier { gu32* bar; unsigned x; volatile LAS unsigned* st; };
__device__ __forceinline__ XcdBarrier xcd_barrier_post(gu32* bar, volatile LAS unsigned* st, bool leader) {
    XcdBarrier b; b.bar = bar; b.x = xb_xcc_id(); b.st = st;
    if (leader) (void)xb_add(&bar[XB_XCNT(b.x)], 1u);
    return b;
}
__device__ __forceinline__ void xcd_barrier_complete(gu32* bar, unsigned x, unsigned& nloc, unsigned& nx) {
    const unsigned G = gridDim.x * gridDim.y * gridDim.z;
    unsigned sum, cnt, mine, sp = 0u;
    for (;;) {
        sum = 0u; cnt = 0u; mine = 0u;
#pragma unroll
        for (unsigned j = 0; j < 16; ++j) { const unsigned c = xb_ld(&bar[XB_XCNT(j)]); sum += c; cnt += (c > 0u) ? 1u : 0u; mine = (j == x) ? c : mine; }
        if (sum == G) break;
        __builtin_amdgcn_s_sleep(1);
        if ((++sp & 255u) == 0u) { if (xb_ld(&bar[XB_TMO])) break; if (sp > XB_SPIN_CAP) { (void)xb_add(&bar[XB_TMO], 1u); break; } }
    }
    nloc = mine > 0u ? mine : 1u; nx = cnt > 0u ? cnt : 1u;
}
__device__ __forceinline__ void xcd_barrier(const XcdBarrier& b, bool leader) {
    asm volatile("s_waitcnt vmcnt(0)" ::: "memory");
    __syncthreads();
    if (leader) {
        gu32* bar = b.bar; asm volatile("" : "+s"(bar));
        __builtin_amdgcn_s_waitcnt(0);
        unsigned nloc = b.st[0], nx = b.st[1];
        if (nloc == 0u) { xcd_barrier_complete(bar, b.x, nloc, nx); b.st[0] = nloc; b.st[1] = nx; }
        const unsigned old = xb_add(&bar[XB_XSUB(b.x)], 1u);
        const unsigned gen = old / nloc;
        if (old + 1u == (gen + 1u) * nloc) {
            __builtin_amdgcn_fence(__ATOMIC_RELEASE, "agent");
            asm volatile("s_waitcnt vmcnt(0)" ::: "memory");
            asm volatile("buffer_inv sc1" ::: "memory");
            const unsigned og = xb_add(&bar[XB_TOP], 1u);
            const unsigned tg = og / nx;
            if (og + 1u == (tg + 1u) * nx) xb_add(&bar[XB_TOPGEN], 1u);
            else XB_SPIN(xb_ld(&bar[XB_TOPGEN]) == tg, bar);
            xb_add(&bar[XB_XGEN(b.x)], 1u);
            asm volatile("s_waitcnt vmcnt(0)" ::: "memory");
        } else {
            asm volatile("buffer_inv sc1" ::: "memory");
            XB_SPIN(xb_ld(&bar[XB_XGEN(b.x)]) == gen, bar);
            asm volatile("s_waitcnt vmcnt(0)" ::: "memory");
        }
    }
    __syncthreads();
}

struct Args { const float* in[22]; float* out; unsigned char* ws; int ph_lo, ph_hi; };
typedef const Args __attribute__((address_space(4)))* ArgsP;
struct Frame {
    unsigned char* sm;
    LAS unsigned char* lds;
    gu32* ctl;
    gu8* ws;
    int tid, lane, wave, G, bid;
    ArgsP ap;
    gfloat* out;
};
#define WSP(T_, off) ((GAS T_*)(F.ws + (off)))
#define FIN(i) ((const gfloat*)F.ap->in[i])
__device__ __forceinline__ void frame_init(Frame& F, unsigned char* lds, int wave0) {
    int ln; asm volatile("v_mbcnt_lo_u32_b32 %0, -1, 0\n\tv_mbcnt_hi_u32_b32 %0, -1, %0" : "=v"(ln));
    int wv = wave0; asm volatile("" : "+s"(wv));
    F.lane = ln; F.wave = wv; F.tid = wv * 64 + ln;
    int bid = blockIdx.x; asm volatile("" : "+s"(bid)); F.bid = bid; F.G = gridDim.x;
    ArgsP ap = (ArgsP)__builtin_amdgcn_kernarg_segment_ptr(); asm volatile("" : "+s"(ap)); F.ap = ap;
    gu8* ws = (gu8*)ap->ws; asm volatile("" : "+s"(ws)); F.ws = ws; F.ctl = (gu32*)(ws + WS_CTL);
    gfloat* out = (gfloat*)ap->out; asm volatile("" : "+s"(out)); F.out = out;
    F.sm = lds; F.lds = (LAS unsigned char*)lds;
}

__device__ __forceinline__ void transpose_item(const gfloat* W, int ldw, int k0, int n0, gbf16* WT, int K, size_t row_base, float* scr, int lane) {
#pragma unroll 8
    for (int i = 0; i < 32; ++i) { const int kk = 2 * i + (lane >> 5); scr[kk * 33 + (lane & 31)] = W[(size_t)(k0 + kk) * ldw + n0 + (lane & 31)]; }
    asm volatile("s_waitcnt lgkmcnt(0)" ::: "memory");
    const int c = lane & 7;
#pragma unroll
    for (int j = 0; j < 4; ++j) { const int n = (lane >> 3) + 8 * j; const float* s = scr + (8 * c) * 33 + n;
        u32x4 o; o.x = pk2(s[0 * 33], s[1 * 33]); o.y = pk2(s[2 * 33], s[3 * 33]); o.z = pk2(s[4 * 33], s[5 * 33]); o.w = pk2(s[6 * 33], s[7 * 33]);
        *(GAS u32x4*)(WT + (row_base + n) * (size_t)K + k0 + 8 * c) = o; }
    asm volatile("s_waitcnt lgkmcnt(0)" ::: "memory");
}
__device__ __forceinline__ bool dense_items(int& r, const gfloat* W, int K, int N, int ldw, gbf16* WT, float* scr, int lane) {
    const int nb = N / 32, items = (K / 64) * nb;
    if (r >= items) { r -= items; return false; }
    const int kb = r / nb, n0 = 32 * (r % nb);
    transpose_item(W, ldw, 64 * kb, n0, WT, K, (size_t)n0, scr, lane);
    return true;
}

__device__ __forceinline__ void quant_item_wg(Frame& F, const gfloat* W, int ldw, int n0, gu8* WQ, gfloat* SB, size_t row_base, int par) {
    float* scr = (float*)(F.sm + F.wave * 16896);
    float* cm = (float*)(F.sm + 135168 + par * 1024);
    const int nl = F.lane & 31, kh = F.lane >> 5;
    const gfloat* src = W + (size_t)(128 * F.wave + kh) * ldw + n0 + nl;
    float mx = 0.f;
#pragma unroll 16
    for (int i = 0; i < 64; ++i) { const float x = src[(size_t)(2 * i) * ldw]; scr[(2 * i + kh) * 33 + nl] = x; mx = fmaxf(mx, fabsf(x)); }
    mx = fmaxf(mx, shfl_xor_l(mx, 32, F.lane));
    if (F.lane < 32) cm[F.wave * 32 + nl] = mx;
    __syncthreads();
    const int c = F.lane & 7;
#pragma unroll
    for (int j = 0; j < 4; ++j) { const int n = (F.lane >> 3) + 8 * j;
        float m = cm[n];
#pragma unroll
        for (int w = 1; w < 8; ++w) m = fmaxf(m, cm[w * 32 + n]);
        m = fmaxf(m, 1e-30f);
        const float inv = 127.f / m;
        const float* sp = scr + (16 * c) * 33 + n;
        u32x4 o;
        o.x = pkq4(sp[0 * 33] * inv, sp[1 * 33] * inv, sp[2 * 33] * inv, sp[3 * 33] * inv);
        o.y = pkq4(sp[4 * 33] * inv, sp[5 * 33] * inv, sp[6 * 33] * inv, sp[7 * 33] * inv);
        o.z = pkq4(sp[8 * 33] * inv, sp[9 * 33] * inv, sp[10 * 33] * inv, sp[11 * 33] * inv);
        o.w = pkq4(sp[12 * 33] * inv, sp[13 * 33] * inv, sp[14 * 33] * inv, sp[15 * 33] * inv);
        *(GAS u32x4*)(WQ + (row_base + n) * (size_t)1024 + 128 * F.wave + 16 * c) = o;
        if (F.wave == 0 && c == 0) SB[row_base + n] = m * (1.f / 127.f); }
    asm volatile("s_waitcnt lgkmcnt(0)" ::: "memory");
}

__device__ __forceinline__ void p0_prologue(Frame& F) {
    float* scr = (float*)(F.sm + F.wave * 16384);
    const int gw = F.bid * NWAVES + F.wave, NGW = F.G * NWAVES;
    {
        constexpr int NB_ML = ML_N / 32, NB_SW = SW_N / 32, NIT = 2 * (NB_ML + NB_SW);
        int par = 0;
        for (int it = F.bid; it < NIT; it += F.G, par ^= 1) {
            const int j = it / (NB_ML + NB_SW), r = it - j * (NB_ML + NB_SW);
            if (r < NB_ML) quant_item_wg(F, FIN(6) + (size_t)j * D * ML_IN, ML_IN, 32 * r, WSP(unsigned char, WS_WMLIN) + (size_t)j * ML_N * D, WSP(float, WS_SBIN) + j * ML_N, (size_t)(32 * r), par);
            else quant_item_wg(F, FIN(10) + (size_t)j * D * SW_N, SW_N, 32 * (r - NB_ML), WSP(unsigned char, WS_WSWIN) + (size_t)j * SW_N * D, WSP(float, WS_SBIN) + 8192 + j * SW_N, (size_t)(32 * (r - NB_ML)), par);
        }
        for (int it = F.bid; it < 4 * 32; it += F.G, par ^= 1) {
            const int mj = it >> 5, nb = it & 31, jj = mj & 1;
            if (mj < 2) quant_item_wg(F, FIN(9) + (size_t)jj * D * D, D, 32 * nb, WSP(unsigned char, WS_WMLOUT) + (size_t)jj * D * D, WSP(float, WS_SBOUT) + jj * D, (size_t)(32 * nb), par);
            else quant_item_wg(F, FIN(14) + (size_t)jj * D * D, D, 32 * nb, WSP(unsigned char, WS_WSWOUT) + (size_t)jj * D * D, WSP(float, WS_SBOUT) + 2 * D + jj * D, (size_t)(32 * nb), par);
        }
        __syncthreads();
    }
    {
        constexpr int I2 = 6 * 32;
        const int NIT = DEPTH * NE * I2;
        for (int it = gw; it < NIT; it += NGW) {
            const int le = it / I2; const int r = it - le * I2;
            const int kb = r / 32, n0 = 32 * (r % 32);
            const gfloat* W = FIN(21) + (size_t)le * DE * D;
            transpose_item(W, D, 64 * kb, n0, WSP(bf16_t, WS_W2), DE, (size_t)le * D + n0, scr, F.lane);
        }
        __syncthreads();
        {
            const int NITQ = DEPTH * NE * 24;
            int par = 0;
            for (int it = F.bid; it < NITQ; it += F.G, par ^= 1) {
                const int le = it / 24, r = it - le * 24, which = r / 12, n0 = 32 * (r % 12);
                const gfloat* W = FIN(which ? 20 : 19) + (size_t)le * D * DE;
                const size_t rb = (size_t)le * 768 + (size_t)(n0 / 128) * 256 + (which ? 128 : 0) + (n0 % 128);
                quant_item_wg(F, W, DE, n0, WSP(unsigned char, WS_W13), WSP(float, WS_SB13), rb, par);
            }
        }
        __syncthreads();
    }
    {
        const int gt = F.bid * NTHREADS + F.tid, NGT = F.G * NTHREADS;
        for (int idx = gt; idx < DEPTH * NRT * D; idx += NGT) {
            const int l = idx / (NRT * D), rem = idx - l * NRT * D, n = rem / D, k = rem - n * D;
            float v = 0.f;
            if (n < 8) v = FIN(15)[((size_t)l * D + k) * 8 + n]; else if (n < 72) v = FIN(17)[((size_t)l * D + k) * 64 + (n - 8)];
            WSP(bf16_t, WS_WRT)[idx] = (bf16_t)f2bf(v);
        }
        for (int idx = gt; idx < 2 * 16 * D; idx += NGT) {
            const int j = idx / (16 * D), rem = idx - j * 16 * D, n = rem / D, k = rem - n * D;
            float v = 0.f;
            if (n < 8) v = FIN(6)[((size_t)j * D + k) * ML_IN + ML_N + n];
            WSP(bf16_t, WS_WMLG)[idx] = (bf16_t)f2bf(v);
        }
    }
    {
        const int NIT = DEPTH * 16 * 96;
        for (int it = gw; it < NIT; it += NGW) {
            const int l = it / (16 * 96), rem = it - l * 16 * 96, kc = rem / 96, jc = rem - kc * 96;
            const int j = jc * 64 + F.lane;
            const gfloat* W = FIN(2) + ((size_t)l * D + kc * 64) * 6144 + j;
            float a0 = 0.f, a1 = 0.f, a2 = 0.f, a3 = 0.f;
#pragma unroll 8
            for (int k = 0; k < 64; ++k) {
                const float w = W[(size_t)k * 6144];
                const int kk = kc * 64 + k;
                const float c0 = FIN(1)[kk], c1 = FIN(1)[D + kk], c2 = FIN(1)[2 * D + kk], c3 = FIN(1)[3 * D + kk];
                a0 += c0 * sigmoidf_(c0) * w; a1 += c1 * sigmoidf_(c1) * w; a2 += c2 * sigmoidf_(c2) * w; a3 += c3 * sigmoidf_(c3) * w;
            }
            gfloat* o = WSP(float, WS_MODP) + (((size_t)kc * DEPTH + l) * 4) * 6144 + j;
            o[0] = a0; o[6144] = a1; o[2 * 6144] = a2; o[3 * 6144] = a3;
        }
    }
}
__device__ __forceinline__ void p0b_modfinal(Frame& F) {
    const int gt = F.bid * NTHREADS + F.tid, NGT = F.G * NTHREADS;
    for (int idx = gt; idx < DEPTH * 4 * 6144; idx += NGT) {
        const int l = idx / (4 * 6144), j = idx % 6144;
        float s = FIN(3)[l * 6144 + j];
#pragma unroll
        for (int kc = 0; kc < 16; ++kc) s += WSP(float, WS_MODP)[(size_t)kc * DEPTH * 4 * 6144 + idx];
        WSP(float, WS_MOD)[idx] = s;
    }
}

__device__ __forceinline__ void build_moe_tables(Frame& F, int layer) {
    int* blk2e = (int*)(F.sm + TAB_BLK2E); int* blkstart = (int*)(F.sm + TAB_BLKSTART); int* cnt = (int*)(F.sm + TAB_CNT); int* nblk = (int*)(F.sm + TAB_NBLK);
    __syncthreads();
    if (F.wave == 0) {
        const int c = (int)__hip_atomic_load(F.ctl + CW_CNT + 64 * layer + F.lane, __ATOMIC_RELAXED, __HIP_MEMORY_SCOPE_AGENT);
        const int nb = (c + 255) >> 8;
        int s = nb;
#pragma unroll
        for (int o = 1; o < 64; o <<= 1) { const int t = __builtin_amdgcn_ds_bpermute((F.lane - o) << 2, s); if (F.lane >= o) s += t; }
        const int st = s - nb;
        cnt[F.lane] = c; blkstart[F.lane] = st;
        for (int j = 0; j < nb; ++j) blk2e[st + j] = F.lane;
        if (F.lane == 63) { blkstart[NE] = s; nblk[0] = s; }
        const int nlab = (F.G % 8 == 0) ? 8 : 1, lab = F.bid % nlab;
        const bool mine = (F.lane % nlab) == lab;
        int q = mine ? nb : 0;
#pragma unroll
        for (int o = 1; o < 64; o <<= 1) { const int t = __builtin_amdgcn_ds_bpermute((F.lane - o) << 2, q); if (F.lane >= o) q += t; }
        int* xblk = (int*)(F.sm + TAB_XBLK);
        if (mine) for (int jj = 0; jj < nb; ++jj) xblk[q - nb + jj] = st + jj;
        if (F.lane == 63) nblk[1] = q;
    }
    __syncthreads();
}

template <int MODE>
__device__ __forceinline__ void normp_phase(Frame& F, int layer, int sub, bool combine) {
    constexpr int RG = 2;
    float* LG = (float*)(F.sm);
    float* ZL = (float*)(F.sm + 45056);
    int* lcnt = (int*)(F.sm + 40960);
    int* lbase = lcnt + 64;
    const bool first = (layer == 0 && sub == 0);
    const bool wr_x = combine || first;
    gbf16* xb = WSP(bf16_t, WS_XB);
    const gbf16* xbin = WSP(bf16_t, WS_XB);
    const gfloat* gain = FIN(sub ? 5 : 4) + (size_t)layer * D;
    if (combine) build_moe_tables(F, layer - 1);
    const int* blkstart = (const int*)(F.sm + TAB_BLKSTART);
    const gu8* YS = WSP(unsigned char, WS_YS); const gfloat* YSc = WSP(float, WS_YSS);
    gbf16* HN = WSP(bf16_t, WS_HN);
    gu32* HNQ = WSP(unsigned, WS_HNQ); gfloat* SA = WSP(float, WS_SA);
    u32x2 wg[4][4];
    unsigned char* WGL = F.sm + 49152;
    if (MODE != 0) {
        const gbf16* WTg = WSP(bf16_t, WS_WMLG) + (size_t)(layer >> 1) * 16 * D;
#pragma unroll
        for (int g = 0; g < 4; ++g)
#pragma unroll
            for (int j = 0; j < 4; ++j) wg[g][j] = *(const GAS u32x2*)(WTg + (size_t)g * D + 4 * F.lane + 256 * j);
        *(u32x4*)(WGL + 16 * F.tid) = *(const GAS u32x4*)(WTg + (size_t)4 * D + 8 * F.tid);
        __syncthreads();
    }
    for (int rb = F.bid; rb < T / 128; rb += F.G) {
        const int row0 = rb * 128, b = row0 / SEQ;
        const gfloat* modb = WSP(float, WS_MOD) + ((size_t)layer * 4 + b) * 6144;
        const gfloat* shp = modb + (sub ? 3 : 0) * D; const gfloat* scp = shp + D;
        const gfloat* gtp = WSP(float, WS_MOD) + ((size_t)(layer > 0 ? layer - 1 : 0) * 4 + b) * 6144 + 5 * D;
        f32x4 ga[4], sh[4], gt[4];
#pragma unroll
        for (int j = 0; j < 4; ++j) { const int col = 4 * F.lane + 256 * j;
            const f32x4 g = *(const GAS f32x4*)(gain + col), sc = *(const GAS f32x4*)(scp + col);
            ga[j] = g * (sc + 1.f); sh[j] = *(const GAS f32x4*)(shp + col); gt[j] = combine ? *(const GAS f32x4*)(gtp + col) : (f32x4){0.f, 0.f, 0.f, 0.f}; }
        unsigned ti0 = 0u, ti1 = 0u; float tg0 = 0.f, tg1 = 0.f;
        if (combine && F.lane < 16) { const int row = row0 + 16 * F.wave + F.lane;
            const u32x2 ti = *(const GAS u32x2*)(WSP(unsigned, WS_TOKINFO) + row * 2); const f32x2 tg = *(const GAS f32x2*)(WSP(float, WS_TOKGATE) + row * 2);
            ti0 = ti.x; ti1 = ti.y; tg0 = tg.x; tg1 = tg.y; }
        for (int grp = 0; grp < 16 / RG; ++grp) {
            const int rbase = row0 + 16 * F.wave + RG * grp;
            f32x4 v[RG][4];
#pragma unroll
            for (int i = 0; i < RG; ++i)
#pragma unroll
                for (int j = 0; j < 4; ++j) v[i][j] = (f32x4){0.f, 0.f, 0.f, 0.f};
            u32x2 xw[RG][4];
#pragma unroll
            for (int i = 0; i < RG; ++i)
#pragma unroll
                for (int j = 0; j < 4; ++j) xw[i][j] = (u32x2){0u, 0u};
            if (first) {
#pragma unroll
                for (int i = 0; i < RG; ++i)
#pragma unroll
                    for (int j = 0; j < 4; ++j) v[i][j] = *(const GAS f32x4*)(FIN(0) + (size_t)(rbase + i) * D + 4 * F.lane + 256 * j);
            } else {
#pragma unroll
                for (int i = 0; i < RG; ++i)
#pragma unroll
                    for (int j = 0; j < 4; ++j) xw[i][j] = *(const GAS u32x2*)(xbin + (size_t)(rbase + i) * D + 4 * F.lane + 256 * j);
            }
            if (combine) {
                unsigned y0[RG][4], y1[RG][4]; float z0[RG][4], z1[RG][4]; float g0[RG], g1[RG];
#pragma unroll
                for (int i = 0; i < RG; ++i) {
                    const int li = RG * grp + i;
                    const unsigned i0 = (unsigned)__builtin_amdgcn_readlane((int)ti0, li), i1 = (unsigned)__builtin_amdgcn_readlane((int)ti1, li);
                    g0[i] = __int_as_float(__builtin_amdgcn_readlane(__float_as_int(tg0), li)); g1[i] = __int_as_float(__builtin_amdgcn_readlane(__float_as_int(tg1), li));
                    const size_t s0 = (size_t)blkstart[i0 >> 16] * 256 + (i0 & 0xffffu), s1 = (size_t)blkstart[i1 >> 16] * 256 + (i1 & 0xffffu);
#pragma unroll
                    for (int j = 0; j < 4; ++j) { y0[i][j] = *(const GAS unsigned*)(YS + s0 * D + 4 * F.lane + 256 * j); y1[i][j] = *(const GAS unsigned*)(YS + s1 * D + 4 * F.lane + 256 * j);
                        z0[i][j] = YSc[s0 * 32 + 8 * j + (F.lane >> 3)]; z1[i][j] = YSc[s1 * 32 + 8 * j + (F.lane >> 3)]; }
                }
                asm volatile("" ::: "memory");
#pragma unroll
                for (int i = 0; i < RG; ++i)
#pragma unroll
                    for (int j = 0; j < 4; ++j) {
                        if (!first) v[i][j] = (f32x4){bf2f(xw[i][j].x & 0xffffu), bf2f(xw[i][j].x >> 16), bf2f(xw[i][j].y & 0xffffu), bf2f(xw[i][j].y >> 16)};
                        v[i][j] += gt[j] * (unq4(y0[i][j], g0[i] * z0[i][j]) + unq4(y1[i][j], g1[i] * z1[i][j]));
                    }
            }
            if (!combine && !first) {
#pragma unroll
                for (int i = 0; i < RG; ++i)
#pragma unroll
                    for (int j = 0; j < 4; ++j) v[i][j] = (f32x4){bf2f(xw[i][j].x & 0xffffu), bf2f(xw[i][j].x >> 16), bf2f(xw[i][j].y & 0xffffu), bf2f(xw[i][j].y >> 16)};
            }
            float ss[RG];
#pragma unroll
            for (int i = 0; i < RG; ++i) { ss[i] = 0.f;
#pragma unroll
                for (int j = 0; j < 4; ++j) {
                    if (wr_x) { u32x2 xw; xw.x = pk2(v[i][j].x, v[i][j].y); xw.y = pk2(v[i][j].z, v[i][j].w); *(GAS u32x2*)(xb + (size_t)(rbase + i) * D + 4 * F.lane + 256 * j) = xw;
                        v[i][j] = (f32x4){bf2f(xw.x & 0xffffu), bf2f(xw.x >> 16), bf2f(xw.y & 0xffffu), bf2f(xw.y >> 16)}; }
                    ss[i] += (v[i][j].x * v[i][j].x + v[i][j].y * v[i][j].y) + (v[i][j].z * v[i][j].z + v[i][j].w * v[i][j].w); } }
#pragma unroll
            for (int o = 1; o < 64; o <<= 1) {
#pragma unroll
                for (int i = 0; i < RG; ++i) ss[i] += shfl_xor_l(ss[i], o, F.lane); }
            float mx[RG];
            float zp[RG * 8];
#pragma unroll
            for (int t = 0; t < RG * 8; ++t) zp[t] = 0.f;
#pragma unroll
            for (int i = 0; i < RG; ++i) { const float r = rsqrtf(ss[i] * (1.f / D) + EPS); mx[i] = 0.f;
#pragma unroll
                for (int j = 0; j < 4; ++j) { const f32x4 hv = v[i][j] * r * ga[j] + sh[j]; v[i][j] = hv;
                    mx[i] = fmaxf(fmaxf(mx[i], fmaxf(fabsf(hv.x), fabsf(hv.y))), fmaxf(fabsf(hv.z), fabsf(hv.w)));
                } }
            if (MODE != 0) {
#pragma unroll
                for (int j = 0; j < 4; ++j) {
                    u32x2 wl[4];
#pragma unroll
                    for (int g = 0; g < 4; ++g) wl[g] = *(const u32x2*)(WGL + g * 2048 + (4 * F.lane + 256 * j) * 2);
#pragma unroll
                    for (int i = 0; i < RG; ++i) { const unsigned w0 = pk2(v[i][j].x, v[i][j].y), w1 = pk2(v[i][j].z, v[i][j].w);
#pragma unroll
                        for (int g = 0; g < 4; ++g) { zp[i * 8 + g] = dot2bf(w1, wg[g][j].y, dot2bf(w0, wg[g][j].x, zp[i * 8 + g]));
                            zp[i * 8 + 4 + g] = dot2bf(w1, wl[g].y, dot2bf(w0, wl[g].x, zp[i * 8 + 4 + g])); } } }
            }
            if (MODE != 0) {
                static_assert(RG == 2, "butterfly below is written for 16 values");
                const int ln = F.lane;
#pragma unroll
                for (int n = 8, o = 32; n >= 1; n >>= 1, o >>= 1) { const bool hi = (ln & o) != 0;
#pragma unroll
                    for (int t = 0; t < 8; ++t) if (t < n) { const float keep = hi ? zp[n + t] : zp[t], give = hi ? zp[t] : zp[n + t]; zp[t] = keep + shfl_xor_l(give, o, ln); } }
                zp[0] += shfl_xor_l(zp[0], 2, ln); zp[0] += shfl_xor_l(zp[0], 1, ln);
                const int vi = ((ln >> 5) & 1) * 8 + ((ln >> 4) & 1) * 4 + ((ln >> 3) & 1) * 2 + ((ln >> 2) & 1);
                if ((ln & 3) == 0) LG[(16 * F.wave + RG * grp + (vi >> 3)) * NRT + (vi & 7)] = zp[0];
            }
#pragma unroll
            for (int o = 1; o < 64; o <<= 1) {
#pragma unroll
                for (int i = 0; i < RG; ++i) mx[i] = fmaxf(mx[i], shfl_xor_l(mx[i], o, F.lane)); }
#pragma unroll
            for (int i = 0; i < RG; ++i) { const float m_ = fmaxf(mx[i], 1e-30f), inv = 127.f * frcp(m_);
#pragma unroll
                for (int j = 0; j < 4; ++j) HNQ[(size_t)(rbase + i) * (D / 4) + F.lane + 64 * j] = pkq4(v[i][j].x * inv, v[i][j].y * inv, v[i][j].z * inv, v[i][j].w * inv);
                if (F.lane == 0) SA[rbase + i] = m_ * (1.f / 127.f); }
        }
        if (MODE != 0) {
            __syncthreads();
            {
                for (int idx = F.tid; idx < 128 * 8; idx += NTHREADS) {
                    const int r = idx >> 3, gi = idx & 7, row = row0 + r;
                    float z = LG[r * NRT + gi] + FIN(7)[(layer >> 1) * 8 + gi];
                    z = GATE_CAP * (1.f - 2.f / (__expf(z * (2.f / GATE_CAP)) + 1.f));
                    if (gi >= 4) z = fminf(z, 0.f) - __logf(1.f + __expf(-fabsf(z)));
                    if (gi < 4) WSP(float, WS_IG)[row * 4 + gi] = z; else WSP(float, WS_LF)[row * 4 + gi - 4] = z;
                    ZL[gi * 128 + r] = z;
                }
                __syncthreads();
                if (F.wave < ML_H) {
                    const int h = F.wave, l = F.lane;
                    const f32x2 lfp = *(const f32x2*)(ZL + (4 + h) * 128 + 2 * l), igp = *(const f32x2*)(ZL + h * 128 + 2 * l);
                    float s = lfp.x + lfp.y;
#pragma unroll
                    for (int o = 1; o < 64; o <<= 1) { const float t = shfl_up_l(s, o, l); if (l >= o) s += t; }
                    const float ex = s - (lfp.x + lfp.y);
                    const float b0 = ex + lfp.x, b1 = b0 + lfp.y, p0 = igp.x - b0, p1 = igp.y - b1;
                    float m = fmaxf(p0, p1);
#pragma unroll
                    for (int o = 1; o < 64; o <<= 1) { const float t = shfl_up_l(m, o, l); if (l >= o) m = fmaxf(m, t); }
                    float mex = shfl_up_l(m, 1, l); if (l == 0) mex = -INFINITY;
                    const int u = ((row0 / SEQ) * ML_H + h) * NCH + (row0 % SEQ) / LC;
                    gfloat* cx = WSP(float, WS_CSX) + (size_t)u * 384;
                    *(GAS f32x2*)(cx + 2 * l) = (f32x2){b0, b1}; *(GAS f32x2*)(cx + 128 + 2 * l) = (f32x2){p0, p1};
                    *(GAS f32x2*)(cx + 256 + 2 * l) = (f32x2){fmaxf(mex, p0), fmaxf(mex, fmaxf(p0, p1))};
                    if (l == 63) WSP(float, WS_CSM)[u] = m;
                }
                __syncthreads();
            }
        }
    }
}

__device__ __forceinline__ void normp_router(Frame& F, int layer) {
    constexpr int WS_ = 528;
    constexpr int WB_OFF = 0, LG_OFF = 80 * WS_, GA_OFF = LG_OFF + 128 * NRT * 4, SH_OFF = GA_OFF + 4096, BI_OFF = SH_OFF + 4096, LC_OFF = BI_OFF + 512;
    float* LG = (float*)(F.sm + LG_OFF); float* GA = (float*)(F.sm + GA_OFF); float* SH = (float*)(F.sm + SH_OFF); float* BI = (float*)(F.sm + BI_OFF);
    int* lcnt = (int*)(F.sm + LC_OFF); int* lbase = lcnt + 64; float* RS = (float*)(F.sm + LC_OFF + 512);
    LAS unsigned char* L = F.lds;
    const gbf16* XBp = WSP(bf16_t, WS_XB); gu8* HNQ = WSP(unsigned char, WS_HNQ);
    const gbf16* WT = WSP(bf16_t, WS_WRT) + (size_t)layer * NRT * D;
    const int fr = F.lane & 15, fq = F.lane >> 4;
    for (int rb = F.bid; rb < T / 128; rb += F.G) {
        const int row0 = rb * 128, b = row0 / SEQ;
        const gfloat* modb = WSP(float, WS_MOD) + ((size_t)layer * 4 + b) * 6144;
        __syncthreads();
        for (int i = F.tid; i < D / 4; i += NTHREADS) { const f32x4 g = *(const GAS f32x4*)(FIN(5) + (size_t)layer * D + 4 * i), sc = *(const GAS f32x4*)(modb + 4 * D + 4 * i);
            *(f32x4*)(GA + 4 * i) = g * (sc + 1.f); *(f32x4*)(SH + 4 * i) = *(const GAS f32x4*)(modb + 3 * D + 4 * i); }
        if (F.tid < 72) BI[F.tid] = (F.tid < 8) ? FIN(16)[layer * 8 + F.tid] : FIN(18)[layer * 64 + F.tid - 8];
        if (F.tid < 64) lcnt[F.tid] = 0;
        const int row = row0 + 16 * F.wave + fr;
        const GAS char* xr = (const GAS char*)(XBp + (size_t)row * D + 8 * fq);
        float ss = 0.f;
#pragma unroll
        for (int j0 = 0; j0 < 32; j0 += 8) {
            u32x4 xw[8];
#pragma unroll
            for (int j = 0; j < 8; ++j) xw[j] = *(const GAS u32x4*)(xr + (size_t)(j0 + j) * 64);
#pragma unroll
            for (int j = 0; j < 8; ++j) { float f[8]; unpack8(xw[j], f);
#pragma unroll
                for (int e = 0; e < 8; ++e) ss += f[e] * f[e]; }
        }
        ss += shfl_xor_l(ss, 16, F.lane); ss += shfl_xor_l(ss, 32, F.lane);
        const float r = rsqrtf(ss * (1.f / D) + EPS);
        f32x4 acc[5];
#pragma unroll
        for (int n = 0; n < 5; ++n) acc[n] = (f32x4){0.f, 0.f, 0.f, 0.f};
        float hmx = 0.f;
        __syncthreads();
#pragma unroll
        for (int j0 = 0; j0 < 32; j0 += 8) {
            u32x4 xw[8];
#pragma unroll
            for (int j = 0; j < 8; ++j) xw[j] = *(const GAS u32x4*)(xr + (size_t)(j0 + j) * 64);
#pragma unroll
            for (int j = 0; j < 8; ++j) { float f[8]; unpack8(xw[j], f);
                const int col = 32 * (j0 + j) + 8 * fq;
                const f32x4 g0 = *(const f32x4*)(GA + col), g1 = *(const f32x4*)(GA + col + 4), s0 = *(const f32x4*)(SH + col), s1 = *(const f32x4*)(SH + col + 4);
#pragma unroll
                for (int e = 0; e < 4; ++e) hmx = fmaxf(hmx, fmaxf(fabsf(f[e] * r * g0[e] + s0[e]), fabsf(f[4 + e] * r * g1[e] + s1[e]))); }
        }
        hmx = fmaxf(hmx, shfl_xor_l(hmx, 16, F.lane)); hmx = fmaxf(hmx, shfl_xor_l(hmx, 32, F.lane));
        const float m_ = fmaxf(hmx, 1e-30f), inv = 127.f * frcp(m_);
        if (fq == 0) RS[16 * F.wave + fr] = m_ * (1.f / 127.f);
        GAS char* qr = (GAS char*)HNQ + (size_t)row * D;
        for (int kc = 0; kc < 4; ++kc) {
            __syncthreads();
#pragma unroll
            for (int i = 0; i < 5; ++i) { const int idx = F.tid + NTHREADS * i, n = idx >> 5, c16 = idx & 31;
                *(u32x4*)(F.sm + WB_OFF + n * WS_ + c16 * 16) = *(const GAS u32x4*)(WT + (size_t)n * D + 256 * kc + 8 * c16); }
            u32x4 xw[8];
#pragma unroll
            for (int j = 0; j < 8; ++j) xw[j] = *(const GAS u32x4*)(xr + (size_t)(8 * kc + j) * 64);
            __syncthreads();
#pragma unroll
            for (int j = 0; j < 8; ++j) {
                const int col = 256 * kc + 32 * j + 8 * fq;
                float f[8]; unpack8(xw[j], f);
                const f32x4 g0 = *(const f32x4*)(GA + col), g1 = *(const f32x4*)(GA + col + 4), s0 = *(const f32x4*)(SH + col), s1 = *(const f32x4*)(SH + col + 4);
                float h[8];
#pragma unroll
                for (int e = 0; e < 4; ++e) { h[e] = f[e] * r * g0[e] + s0[e]; h[4 + e] = f[4 + e] * r * g1[e] + s1[e]; }
                u32x4 hw;
                hw.x = pk2(h[0], h[1]); hw.y = pk2(h[2], h[3]); hw.z = pk2(h[4], h[5]); hw.w = pk2(h[6], h[7]);
                { u32x2 q; q.x = pkq4(h[0] * inv, h[1] * inv, h[2] * inv, h[3] * inv); q.y = pkq4(h[4] * inv, h[5] * inv, h[6] * inv, h[7] * inv);
                  *(GAS u32x2*)(qr + col) = q; }
                const bf16x8 a = __builtin_bit_cast(bf16x8, hw);
                bf16x8 bb[5];
#pragma unroll
                for (int n = 0; n < 5; ++n) bb[n] = *(const LAS bf16x8*)(L + WB_OFF + (16 * n + fr) * WS_ + (32 * j + 8 * fq) * 2);
#pragma unroll
                for (int n = 0; n < 5; ++n) acc[n] = __builtin_amdgcn_mfma_f32_16x16x32_bf16(a, bb[n], acc[n], 0, 0, 0);
            }
        }
#pragma unroll
        for (int n = 0; n < 5; ++n)
#pragma unroll
            for (int jj = 0; jj < 4; ++jj) LG[(16 * F.wave + 4 * fq + jj) * NRT + n * 16 + fr] = acc[n][jj];
        __syncthreads();
        int e0 = 0, e1 = 0, lr0 = 0, lr1 = 0; float gate0 = 0.f, gate1 = 0.f;
        if (F.tid < 128) {
            const float* lg = LG + F.tid * NRT;
            float gl[8]; int gs = 0; float mx = -INFINITY;
#pragma unroll
            for (int jj = 0; jj < 8; ++jj) { gl[jj] = lg[jj] + BI[jj]; if (gl[jj] > mx) { mx = gl[jj]; gs = jj; } }
            float se = 0.f;
#pragma unroll
            for (int jj = 0; jj < 8; ++jj) se += __expf(gl[jj] - mx);
            const float pg = 1.f / se;
            float el[8]; int t1 = 0; float v0 = -INFINITY;
#pragma unroll
            for (int jj = 0; jj < 8; ++jj) { el[jj] = lg[8 + gs * 8 + jj] + BI[8 + gs * 8 + jj]; if (el[jj] > v0) { v0 = el[jj]; t1 = jj; } }
            int t2 = 0; float v1 = -INFINITY;
#pragma unroll
            for (int jj = 0; jj < 8; ++jj) if (jj != t1 && el[jj] > v1) { v1 = el[jj]; t2 = jj; }
            const float ex = __expf(v1 - v0);
            gate0 = pg / (1.f + ex); gate1 = pg * ex / (1.f + ex);
            e0 = gs * 8 + t1; e1 = gs * 8 + t2;
            lr0 = atomicAdd(&lcnt[e0], 1); lr1 = atomicAdd(&lcnt[e1], 1);
        }
        __syncthreads();
        if (F.tid < 64) { const int c = lcnt[F.tid]; lbase[F.tid] = c > 0 ? (int)__hip_atomic_fetch_add(F.ctl + CW_CNT + 64 * layer + F.tid, (unsigned)c, __ATOMIC_RELAXED, __HIP_MEMORY_SCOPE_AGENT) : 0; }
        __syncthreads();
        if (F.tid < 128) {
            const int rw = row0 + F.tid;
            const int r0 = lbase[e0] + lr0, r1 = lbase[e1] + lr1;
            WSP(unsigned, WS_LIST)[(size_t)e0 * CAP + r0] = (unsigned)rw;
            WSP(unsigned, WS_LIST)[(size_t)e1 * CAP + r1] = (unsigned)rw;
            WSP(unsigned, WS_TOKINFO)[rw * 2] = ((unsigned)e0 << 16) | (unsigned)r0;
            WSP(unsigned, WS_TOKINFO)[rw * 2 + 1] = ((unsigned)e1 << 16) | (unsigned)r1;
            WSP(float, WS_TOKGATE)[rw * 2] = gate0; WSP(float, WS_TOKGATE)[rw * 2 + 1] = gate1;
            const float rs = RS[F.tid];
            WSP(float, WS_SAE)[(size_t)e0 * CAP + r0] = rs; WSP(float, WS_SAE)[(size_t)e1 * CAP + r1] = rs;
        }
    }
    __syncthreads();
}

__device__ __forceinline__ void final_phase(Frame& F) {
    build_moe_tables(F, DEPTH - 1);
    const int* blkstart = (const int*)(F.sm + TAB_BLKSTART);
    const gu8* YS = WSP(unsigned char, WS_YS); const gfloat* YSc = WSP(float, WS_YSS);
    const int gw = F.bid * NWAVES + F.wave, NGW = F.G * NWAVES;
    constexpr int NR = 4;
    for (int row0 = NR * gw; row0 < T; row0 += NR * NGW) {
        const int b = row0 / SEQ;
        const gfloat* gtp = WSP(float, WS_MOD) + ((size_t)(DEPTH - 1) * 4 + b) * 6144 + 5 * D;
        u32x2 xw[NR][4]; unsigned y0[NR][4], y1[NR][4]; float z0[NR][4], z1[NR][4]; float g0[NR], g1[NR]; f32x4 gt[4];
#pragma unroll
        for (int i = 0; i < NR; ++i) {
            const int row = row0 + i;
            const unsigned i0 = WSP(unsigned, WS_TOKINFO)[row * 2], i1 = WSP(unsigned, WS_TOKINFO)[row * 2 + 1];
            g0[i] = WSP(float, WS_TOKGATE)[row * 2]; g1[i] = WSP(float, WS_TOKGATE)[row * 2 + 1];
            const size_t s0 = (size_t)blkstart[i0 >> 16] * 256 + (i0 & 0xffffu), s1 = (size_t)blkstart[i1 >> 16] * 256 + (i1 & 0xffffu);
#pragma unroll
            for (int j = 0; j < 4; ++j) {
                xw[i][j] = *(const GAS u32x2*)(WSP(bf16_t, WS_XB) + (size_t)row * D + 4 * F.lane + 256 * j);
                y0[i][j] = *(const GAS unsigned*)(YS + s0 * D + 4 * F.lane + 256 * j); y1[i][j] = *(const GAS unsigned*)(YS + s1 * D + 4 * F.lane + 256 * j);
                z0[i][j] = YSc[s0 * 32 + 8 * j + (F.lane >> 3)]; z1[i][j] = YSc[s1 * 32 + 8 * j + (F.lane >> 3)]; }
        }
#pragma unroll
        for (int j = 0; j < 4; ++j) gt[j] = *(const GAS f32x4*)(gtp + 4 * F.lane + 256 * j);
#pragma unroll
        for (int i = 0; i < NR; ++i)
#pragma unroll
            for (int j = 0; j < 4; ++j) {
                f32x4 v = (f32x4){bf2f(xw[i][j].x & 0xffffu), bf2f(xw[i][j].x >> 16), bf2f(xw[i][j].y & 0xffffu), bf2f(xw[i][j].y >> 16)};
                v += gt[j] * (unq4(y0[i][j], g0[i] * z0[i][j]) + unq4(y1[i][j], g1[i] * z1[i][j]));
                *(GAS f32x4*)(F.out + (size_t)(row0 + i) * D + 4 * F.lane + 256 * j) = v;
            }
    }
}

__device__ __forceinline__ float ml_chunk_scalars(Frame& F, float* sc, int tok0, int h) {
    float mall = 0.f;
    if (F.wave == 0) {
        const int l = F.lane;
        const float lf0 = WSP(float, WS_LF)[(size_t)(tok0 + 2 * l) * 4 + h], lf1 = WSP(float, WS_LF)[(size_t)(tok0 + 2 * l + 1) * 4 + h];
        const float ig0 = WSP(float, WS_IG)[(size_t)(tok0 + 2 * l) * 4 + h], ig1 = WSP(float, WS_IG)[(size_t)(tok0 + 2 * l + 1) * 4 + h];
        float s = lf0 + lf1;
#pragma unroll
        for (int o = 1; o < 64; o <<= 1) { const float t = shfl_up_l(s, o, l); if (l >= o) s += t; }
        const float ex = s - (lf0 + lf1);
        const float b0 = ex + lf0, b1 = b0 + lf1, p0 = ig0 - b0, p1 = ig1 - b1;
        float m = fmaxf(p0, p1);
#pragma unroll
        for (int o = 1; o < 64; o <<= 1) { const float t = shfl_up_l(m, o, l); if (l >= o) m = fmaxf(m, t); }
        float mex = shfl_up_l(m, 1, l); if (l == 0) mex = -INFINITY;
        *(f32x2*)(sc + 2 * l) = (f32x2){lf0, lf1}; *(f32x2*)(sc + 128 + 2 * l) = (f32x2){ig0, ig1};
        *(f32x2*)(sc + 256 + 2 * l) = (f32x2){b0, b1}; *(f32x2*)(sc + 384 + 2 * l) = (f32x2){p0, p1};
        *(f32x2*)(sc + 896 + 2 * l) = (f32x2){fmaxf(mex, p0), fmaxf(mex, fmaxf(p0, p1))};
        mall = __int_as_float(__builtin_amdgcn_readlane(__float_as_int(m), 63));
    }
    return mall;
}
__device__ __forceinline__ void ml_s2_phase(Frame& F) {
    constexpr int Q8 = ST_ELEMS / 8, NIT = NBATCH * ML_H * Q8;
    for (int iw = F.wave * F.G + F.bid; iw * 64 < NIT; iw += F.G * NWAVES) {
        const int idx = iw * 64 + F.lane;
        if (idx < NIT) {
            const int bh = idx / Q8, e8 = (idx - bh * Q8) * 8;
            float st[8], m = 0.f;
#pragma unroll
            for (int e = 0; e < 8; ++e) st[e] = 0.f;
            for (int c0 = 0; c0 < NCH; c0 += 16) {
                u32x4 w[16]; f32x2 ga[16];
#pragma unroll
                for (int k = 0; k < 16; ++k) { const int u = bh * NCH + c0 + k; w[k] = *(const GAS u32x4*)(WSP(bf16_t, WS_UST) + (size_t)u * ST_ELEMS + e8); ga[k] = *(const GAS f32x2*)(WSP(float, WS_CS) + u * 2); }
                asm volatile("" ::: "memory");
#pragma unroll
                for (int k = 0; k < 16; ++k) {
                    const int u = bh * NCH + c0 + k;
                    const float G = ga[k].x, A = ga[k].y;
                    const float mn = fmaxf(G + m, A), decay = __expf(G + m - mn), scale = __expf(A - mn);
                    m = mn;
                    float f[8]; unpack8(w[k], f);
#pragma unroll
                    for (int e = 0; e < 8; ++e) st[e] = decay * st[e] + scale * f[e];
                    u32x4 o; o.x = pk2(st[0], st[1]); o.y = pk2(st[2], st[3]); o.z = pk2(st[4], st[5]); o.w = pk2(st[6], st[7]);
                    st16_wt(WSP(bf16_t, WS_CST) + (size_t)u * ST_ELEMS + e8, o);
                    if (e8 == 0) (WSP(float, WS_CS) + 16384)[u] = m;
                }
            }
        }
    }
}
typedef short v4i16_t __attribute__((ext_vector_type(4)));
__device__ __forceinline__ bf16x8 tr2(const LAS unsigned char* p0, const LAS unsigned char* p1) {
    const v4i16_t x0 = __builtin_amdgcn_ds_read_tr16_b64_v4i16((LAS v4i16_t*)p0), x1 = __builtin_amdgcn_ds_read_tr16_b64_v4i16((LAS v4i16_t*)p1);
    return __builtin_shufflevector(x0, x1, 0, 1, 2, 3, 4, 5, 6, 7);
}
__device__ __forceinline__ bf16x8 scale_frag(bf16x8 q, float s) {
    u32x4 w = __builtin_bit_cast(u32x4, q); float f[8]; unpack8(w, f);
    u32x4 o; o.x = pk2(f[0] * s, f[1] * s); o.y = pk2(f[2] * s, f[3] * s); o.z = pk2(f[4] * s, f[5] * s); o.w = pk2(f[6] * s, f[7] * s);
    return __builtin_bit_cast(bf16x8, o);
}
__device__ __forceinline__ u32x4 q16bf(u32x4 a, u32x4 b, float inv) {
    float f[8], g[8]; unpack8(a, f); unpack8(b, g);
    u32x4 q; q.x = pkq4(f[0] * inv, f[1] * inv, f[2] * inv, f[3] * inv); q.y = pkq4(f[4] * inv, f[5] * inv, f[6] * inv, f[7] * inv);
    q.z = pkq4(g[0] * inv, g[1] * inv, g[2] * inv, g[3] * inv); q.w = pkq4(g[4] * inv, g[5] * inv, g[6] * inv, g[7] * inv);
    return q;
}
__device__ __forceinline__ unsigned rsq4(unsigned w, float r) {
    const int iw = (int)w;
    return pkq4((float)((iw << 24) >> 24) * r, (float)((iw << 16) >> 24) * r, (float)((iw << 8) >> 24) * r, (float)(iw >> 24) * r);
}
template <int SH>
__device__ __forceinline__ void mix_rescale(Frame& F, int tok, int fr, int fq, const float* hsc) {
    constexpr int NH = 16 >> SH;
    float S = 0.f;
#pragma unroll
    for (int h = 0; h < NH; ++h) S = fmaxf(S, hsc[h * 16 + fr]);
    if (fq == 0) WSP(float, WS_SAM)[tok] = S * (1.f / 127.f);
    const float iS = frcp(S);
    GAS char* p = (GAS char*)WSP(unsigned char, WS_MIXQ) + (size_t)tok * D + 16 * fq;
    asm volatile("s_waitcnt vmcnt(0)" ::: "memory");
#pragma unroll
    for (int p0 = 0; p0 < 16; p0 += 8) {
        u32x4 a[8];
#pragma unroll
        for (int i = 0; i < 8; ++i) a[i] = *(const GAS u32x4*)(p + 64 * (p0 + i));
        asm volatile("" ::: "memory");
#pragma unroll
        for (int i = 0; i < 8; ++i) { const float r = hsc[((p0 + i) >> SH) * 16 + fr] * iS;
            u32x4 q; q.x = rsq4(a[i].x, r); q.y = rsq4(a[i].y, r); q.z = rsq4(a[i].z, r); q.w = rsq4(a[i].w, r);
            *(GAS u32x4*)(p + 64 * (p0 + i)) = q; }
    }
}
__device__ __forceinline__ int mix_unit(const Frame& F, int it) { const int blk = F.bid + (it >> 2) * F.G; return blk < T / 128 ? ((((blk >> 6) * 4 + (it & 3)) << 6) + (blk & 63)) : -1; }

__device__ __forceinline__ void ml_s3_mfma(Frame& F, int j) {
    constexpr int QS = 272, VS = 528, Q_OFF = 4096, K_OFF = Q_OFF + 128 * QS, V_OFF = K_OFF + 128 * QS;
    float* sc = (float*)(F.sm);
    LAS unsigned char* L = F.lds;
    const gbf16* P = WSP(bf16_t, WS_PROJ);
    const gfloat* MC = WSP(float, WS_CS) + 16384;
    const int w = F.wave, t0 = 16 * w;
    u32x4 tq[4], tk[4];
#define S3_LOAD(uu) do { const int c_ = (uu) % NCH, bh_ = (uu) / NCH, h_ = bh_ % ML_H, b_ = bh_ / ML_H, tk0_ = b_ * SEQ + c_ * LC; int tl_ = F.tid; asm volatile("" : "+v"(tl_)); \
        _Pragma("unroll") for (int i = 0; i < 4; ++i) { const int idx = tl_ + NTHREADS * i, s = idx >> 4, d8 = (idx & 15) * 8; \
            tq[i] = *(const GAS u32x4*)(P + (size_t)(tk0_ + s) * ML_N + h_ * ML_DK + d8); tk[i] = *(const GAS u32x4*)(P + (size_t)(tk0_ + s) * ML_N + 512 + h_ * ML_DK + d8); } \
        } while (0)
#define S3_LOAD_V(uu) do { const int c_ = (uu) % NCH, bh_ = (uu) / NCH, h_ = bh_ % ML_H, b_ = bh_ / ML_H, tk0_ = b_ * SEQ + c_ * LC; int tl_ = F.tid; asm volatile("" : "+v"(tl_)); \
        _Pragma("unroll") for (int i = 0; i < 8; ++i) { const int idx = tl_ + NTHREADS * i, s = idx >> 5, d8 = (idx & 31) * 8; \
            tv[i] = *(const GAS u32x4*)(P + (size_t)(tk0_ + s) * ML_N + 1024 + h_ * ML_DV + d8); } } while (0)
    { const int u0 = mix_unit(F, 0); if (u0 >= 0) S3_LOAD(u0); }
    float tmx = 0.f;
    for (int it = 0; ; ++it) {
        const int u = mix_unit(F, it); if (u < 0) break;
        const int c = u % NCH, bh = u / NCH, h = bh % ML_H, b = bh / ML_H, tok0 = b * SEQ + c * LC;
        int ln_ = F.lane; asm volatile("" : "+v"(ln_));
        const int fr = ln_ & 15, fq = ln_ >> 4;
        if (F.wave == 0) {
            const gfloat* cx = WSP(float, WS_CSX) + (size_t)u * 384;
            const float m_in = (c == 0) ? 0.f : MC[u - 1];
            const f32x2 bb = *(const GAS f32x2*)(cx + 2 * F.lane), pp = *(const GAS f32x2*)(cx + 128 + 2 * F.lane), ml = *(const GAS f32x2*)(cx + 256 + 2 * F.lane);
            *(f32x2*)(sc + 384 + 2 * F.lane) = pp;
            const float mp0 = fmaxf(m_in, ml.x), mp1 = fmaxf(m_in, ml.y);
            *(f32x2*)(sc + 512 + 2 * F.lane) = (f32x2){mp0, mp1};
            *(f32x2*)(sc + 640 + 2 * F.lane) = (f32x2){__expf(m_in - mp0), __expf(m_in - mp1)};
            *(f32x2*)(sc + 768 + 2 * F.lane) = (f32x2){__expf(-(bb.x + mp0)), __expf(-(bb.y + mp1))};
        }
        {
            u32x4 tv[8];
            S3_LOAD_V(u);
            int tl = F.tid; asm volatile("" : "+v"(tl));
#pragma unroll
            for (int i = 0; i < 4; ++i) { const int idx = tl + NTHREADS * i, s = idx >> 4, d8 = (idx & 15) * 8;
                *(u32x4*)(F.sm + Q_OFF + s * QS + d8 * 2) = tq[i]; *(u32x4*)(F.sm + K_OFF + s * QS + d8 * 2) = tk[i]; }
#pragma unroll
            for (int i = 0; i < 8; ++i) { const int idx = tl + NTHREADS * i, s = idx >> 5, d8 = (idx & 31) * 8; *(u32x4*)(F.sm + V_OFF + s * VS + d8 * 2) = tv[i]; }
        }
        __syncthreads();
        const int t = t0 + fr;
        const int tok = tok0 + t;
        const float mp_t = sc[512 + t], wi_t = sc[640 + t], emt_t = sc[768 + t];
        bf16x8 qf[4];
#pragma unroll
        for (int ks = 0; ks < 4; ++ks) qf[ks] = *(const LAS bf16x8*)(L + Q_OFF + t * QS + (32 * ks + 8 * fq) * 2);
        f32x4 acc[16], accd = (f32x4){0.f, 0.f, 0.f, 0.f};
#pragma unroll
        for (int nt = 0; nt < 16; ++nt) acc[nt] = (f32x4){0.f, 0.f, 0.f, 0.f};
        if (c > 0) {
            const GAS char* cbs = (const GAS char*)(WSP(bf16_t, WS_CST) + (size_t)(u - 1) * ST_ELEMS);
            int ts = F.tid; asm volatile("" : "+v"(ts));
            const unsigned g0 = (unsigned)(ts >> 2) * 256u + (unsigned)(ts & 3) * 16u, g1 = g0 + 128u * 256u;
            const unsigned l0 = Q_OFF + (unsigned)(ts >> 2) * 80u + 16u * (unsigned)((ts & 3) ^ ((ts >> 6) & 3)), l1 = l0 + 128u * 80u;
            u32x4 s0, s1, s2 = (u32x4){0u, 0u, 0u, 0u};
#define S3_SLICE_LOAD(ks_) do { s0 = *(const GAS u32x4*)(cbs + g0 + 64 * (ks_)); s1 = *(const GAS u32x4*)(cbs + g1 + 64 * (ks_)); \
                if (ts < 4) s2 = *(const GAS u32x4*)(cbs + 256u * 256u + (unsigned)ts * 16u + 64 * (ks_)); } while (0)
            S3_SLICE_LOAD(0);
            __syncthreads();
            const unsigned fro = Q_OFF + (unsigned)(16 * (fr >> 2) + (fr & 3)) * 80u + 16u * (unsigned)(fq ^ (fr >> 2));
#pragma unroll
            for (int ks = 0; ks < 4; ++ks) {
                *(u32x4*)(F.sm + l0) = s0; *(u32x4*)(F.sm + l1) = s1; if (ts < 4) *(u32x4*)(F.sm + Q_OFF + 256u * 80u + 16u * (unsigned)ts) = s2;
                if (ks < 3) S3_SLICE_LOAD(ks + 1);
                __syncthreads();
                const bf16x8 qs = scale_frag(qf[ks], wi_t);
                bf16x8 ca[17];
#pragma unroll
                for (int nt = 0; nt < 16; ++nt) ca[nt] = *(const LAS bf16x8*)(L + fro + (64 * (nt >> 2) + 4 * (nt & 3)) * 80);
                ca[16] = *(const LAS bf16x8*)(L + Q_OFF + 256 * 80 + 16 * fq);
                asm volatile("" ::: "memory"); __builtin_amdgcn_sched_barrier(0);
#pragma unroll
                for (int nt = 0; nt < 16; ++nt) acc[nt] = __builtin_amdgcn_mfma_f32_16x16x32_bf16(ca[nt], qs, acc[nt], 0, 0, 0);
                accd = __builtin_amdgcn_mfma_f32_16x16x32_bf16(ca[16], qs, accd, 0, 0, 0);
                __builtin_amdgcn_sched_barrier(0);
                __syncthreads();
            }
#undef S3_SLICE_LOAD
        }
        u32x4 ogw[8];
#pragma unroll
        for (int g4 = 0; g4 < 4; ++g4) { ogw[2 * g4] = *(const GAS u32x4*)(P + (size_t)tok * ML_N + 2048 + h * ML_DV + 64 * g4 + 16 * fq); ogw[2 * g4 + 1] = *(const GAS u32x4*)(P + (size_t)tok * ML_N + 2048 + h * ML_DV + 64 * g4 + 16 * fq + 8); }
        const bf16x8 ones = (bf16x8){(short)0x3f80, (short)0x3f80, (short)0x3f80, (short)0x3f80, (short)0x3f80, (short)0x3f80, (short)0x3f80, (short)0x3f80};
        for (int kb = 0; kb <= (w >> 1); ++kb) {
            f32x4 sa = (f32x4){0.f, 0.f, 0.f, 0.f}, sb = (f32x4){0.f, 0.f, 0.f, 0.f};
            {
                bf16x8 ka[4], kc[4];
#pragma unroll
                for (int ks = 0; ks < 4; ++ks) {
                    ka[ks] = *(const LAS bf16x8*)(L + K_OFF + (32 * kb + fr) * QS + (32 * ks + 8 * fq) * 2);
                    kc[ks] = *(const LAS bf16x8*)(L + K_OFF + (32 * kb + 16 + fr) * QS + (32 * ks + 8 * fq) * 2);
                }
                asm volatile("" ::: "memory"); __builtin_amdgcn_sched_barrier(0);
#pragma unroll
                for (int ks = 0; ks < 4; ++ks) {
                    sa = __builtin_amdgcn_mfma_f32_16x16x32_bf16(ka[ks], qf[ks], sa, 0, 0, 0);
                    sb = __builtin_amdgcn_mfma_f32_16x16x32_bf16(kc[ks], qf[ks], sb, 0, 0, 0);
                }
            }
            const f32x4 pa = *(const f32x4*)(sc + 384 + 32 * kb + 4 * fq), pb = *(const f32x4*)(sc + 384 + 32 * kb + 16 + 4 * fq);
            float pw[8];
#pragma unroll
            for (int r = 0; r < 4; ++r) {
                const int s0 = 32 * kb + 4 * fq + r, s1 = s0 + 16;
                pw[r] = (s0 <= t) ? sa[r] * __expf(pa[r] - mp_t) : 0.f;
                pw[4 + r] = (s1 <= t) ? sb[r] * __expf(pb[r] - mp_t) : 0.f;
            }
            u32x4 pk; pk.x = pk2(pw[0], pw[1]); pk.y = pk2(pw[2], pw[3]); pk.z = pk2(pw[4], pw[5]); pk.w = pk2(pw[6], pw[7]);
            const bf16x8 pf = __builtin_bit_cast(bf16x8, pk);
            const LAS unsigned char* vb = L + V_OFF + (32 * kb + 4 * fq + (fr >> 2)) * VS + (16 * (fr & 3)) * 2;
            {
                bf16x8 va[16];
#pragma unroll
                for (int nt = 0; nt < 16; ++nt) { const int co = (64 * (nt >> 2) + 4 * (nt & 3)) * 2; va[nt] = tr2(vb + co, vb + 16 * VS + co); }
                asm volatile("" ::: "memory"); __builtin_amdgcn_sched_barrier(0);
#pragma unroll
                for (int nt = 0; nt < 16; ++nt) acc[nt] = __builtin_amdgcn_mfma_f32_16x16x32_bf16(va[nt], pf, acc[nt], 0, 0, 0);
                accd = __builtin_amdgcn_mfma_f32_16x16x32_bf16(ones, pf, accd, 0, 0, 0);
                __builtin_amdgcn_sched_barrier(0);
            }
        }
        const float dinv = frcp(fmaxf(fabsf(accd[0]), emt_t));
        float ss = 0.f;
#pragma unroll
        for (int nt = 0; nt < 16; ++nt) { acc[nt] = acc[nt] * dinv; ss += (acc[nt][0] * acc[nt][0] + acc[nt][1] * acc[nt][1]) + (acc[nt][2] * acc[nt][2] + acc[nt][3] * acc[nt][3]); }
        ss += shfl_xor_l(ss, 16, F.lane); ss += shfl_xor_l(ss, 32, F.lane);
        const float rinv = rsqrtf(ss * (1.f / ML_DV) + EPS);
        f32x4 gg[16];
#pragma unroll
        for (int g4 = 0; g4 < 4; ++g4)
#pragma unroll
            for (int n4 = 0; n4 < 4; ++n4) gg[4 * g4 + n4] = *(const GAS f32x4*)(FIN(8) + (size_t)j * D + h * ML_DV + 64 * g4 + 16 * fq + 4 * n4);
        u32x4 ow[8];
#pragma unroll
        for (int g4 = 0; g4 < 4; ++g4) {
            float og[16]; { float t8[8]; unpack8(ogw[2 * g4], t8);
#pragma unroll
                for (int i = 0; i < 8; ++i) og[i] = t8[i];
                unpack8(ogw[2 * g4 + 1], t8);
#pragma unroll
                for (int i = 0; i < 8; ++i) og[8 + i] = t8[i]; }
            float r16[16];
#pragma unroll
            for (int n4 = 0; n4 < 4; ++n4)
#pragma unroll
                for (int r = 0; r < 4; ++r) { r16[4 * n4 + r] = acc[4 * g4 + n4][r] * rinv * gg[4 * g4 + n4][r] * sigmoidf_(og[4 * n4 + r]); tmx = fmaxf(tmx, fabsf(r16[4 * n4 + r])); }
            ow[2 * g4].x = pk2(r16[0], r16[1]); ow[2 * g4].y = pk2(r16[2], r16[3]); ow[2 * g4].z = pk2(r16[4], r16[5]); ow[2 * g4].w = pk2(r16[6], r16[7]);
            ow[2 * g4 + 1].x = pk2(r16[8], r16[9]); ow[2 * g4 + 1].y = pk2(r16[10], r16[11]); ow[2 * g4 + 1].z = pk2(r16[12], r16[13]); ow[2 * g4 + 1].w = pk2(r16[14], r16[15]);
        }
        asm volatile("" ::: "memory");
        { const int un = mix_unit(F, it + 1); if (un >= 0) S3_LOAD(un); }
        asm volatile("" ::: "memory");
        {
            float* hsc = (float*)(F.sm + TAB_OFF) + w * 64;
            tmx = fmaxf(tmx, shfl_xor_l(tmx, 16, F.lane)); tmx = fmaxf(tmx, shfl_xor_l(tmx, 32, F.lane));
            const float sh = fmaxf(tmx, 1e-30f), inv = 127.f * frcp(sh);
            if (fq == 0) hsc[(it & 3) * 16 + fr] = sh;
            GAS char* qp = (GAS char*)WSP(unsigned char, WS_MIXQ) + (size_t)tok * D + h * ML_DV + 16 * fq;
#pragma unroll
            for (int g4 = 0; g4 < 4; ++g4) *(GAS u32x4*)(qp + 64 * g4) = q16bf(ow[2 * g4], ow[2 * g4 + 1], inv);
            tmx = 0.f;
            if ((it & 3) == 3) mix_rescale<2>(F, tok, fr, fq, hsc);
        }
        __syncthreads();
    }
}

__device__ __forceinline__ void ml_s1_mfma(Frame& F) {
    constexpr int QS = 272, VS = 528, K_OFF = 4096, V_OFF = K_OFF + 128 * QS;
    float* sc = (float*)(F.sm);
    LAS unsigned char* L = F.lds;
    const gbf16* P = WSP(bf16_t, WS_PROJ);
    const int fr = F.lane & 15, fq = F.lane >> 4, w = F.wave;
    for (int u = F.bid; u < ML_UNITS; u += F.G) {
        const int c = u % NCH, bh = u / NCH, h = bh % ML_H, b = bh / ML_H, tok0 = b * SEQ + c * LC;
        if (F.wave == 0) {
            const gfloat* cx = WSP(float, WS_CSX) + (size_t)u * 384;
            const float Mloc = WSP(float, WS_CSM)[u];
            const f32x2 p = *(const GAS f32x2*)(cx + 128 + 2 * F.lane);
            *(f32x2*)(sc + 512 + 2 * F.lane) = (f32x2){__expf(p.x - Mloc), __expf(p.y - Mloc)};
            if (F.lane == 63) { const float G = cx[LC - 1]; WSP(float, WS_CS)[u * 2] = G; WSP(float, WS_CS)[u * 2 + 1] = G + Mloc; }
        }
        __syncthreads();
        {
            u32x4 tk[4], tv[8];
            int tl = F.tid; asm volatile("" : "+v"(tl));
#pragma unroll
            for (int i = 0; i < 4; ++i) { const int idx = tl + NTHREADS * i, s = idx >> 4, d8 = (idx & 15) * 8; tk[i] = *(const GAS u32x4*)(P + (size_t)(tok0 + s) * ML_N + 512 + h * ML_DK + d8); }
#pragma unroll
            for (int i = 0; i < 8; ++i) { const int idx = tl + NTHREADS * i, s = idx >> 5, d8 = (idx & 31) * 8; tv[i] = *(const GAS u32x4*)(P + (size_t)(tok0 + s) * ML_N + 1024 + h * ML_DV + d8); }
            asm volatile("" ::: "memory");
#pragma unroll
            for (int i = 0; i < 4; ++i) { const int idx = tl + NTHREADS * i, s = idx >> 4, d8 = (idx & 15) * 8; *(bf16x8*)(F.sm + K_OFF + s * QS + d8 * 2) = scale_frag(__builtin_bit_cast(bf16x8, tk[i]), sc[512 + s]); }
#pragma unroll
            for (int i = 0; i < 8; ++i) { const int idx = tl + NTHREADS * i, s = idx >> 5, d8 = (idx & 31) * 8; *(u32x4*)(F.sm + V_OFF + s * VS + d8 * 2) = tv[i]; }
        }
        __syncthreads();
        bf16x8 bfr[3][4];
        const short one = (fr == 0) ? (short)0x3f80 : (short)0;
#pragma unroll
        for (int ks = 0; ks < 4; ++ks) {
            const LAS unsigned char* vb = L + V_OFF + (32 * ks + 4 * fq + (fr >> 2)) * VS + (4 * (fr & 3)) * 2;
#pragma unroll
            for (int q = 0; q < 2; ++q) bfr[q][ks] = tr2(vb + (16 * (2 * w + q)) * 2, vb + 16 * VS + (16 * (2 * w + q)) * 2);
            bfr[2][ks] = (bf16x8){one, one, one, one, one, one, one, one};
        }
        gbf16* U = WSP(bf16_t, WS_UST) + (size_t)u * ST_ELEMS;
#pragma unroll
        for (int m2 = 0; m2 < 4; ++m2) {
            f32x4 acc[3][2];
#pragma unroll
            for (int q = 0; q < 3; ++q) { acc[q][0] = (f32x4){0.f, 0.f, 0.f, 0.f}; acc[q][1] = (f32x4){0.f, 0.f, 0.f, 0.f}; }
            bf16x8 af[4][2];
#pragma unroll
            for (int ks = 0; ks < 4; ++ks)
#pragma unroll
                for (int mm = 0; mm < 2; ++mm) {
                    const int mt = 2 * m2 + mm;
                    const LAS unsigned char* kb = L + K_OFF + (32 * ks + 4 * fq + (fr >> 2)) * QS + (32 * m2 + 8 * (fr & 3) + 4 * mm) * 2;
                    af[ks][mm] = tr2(kb, kb + 16 * QS);
                }
            asm volatile("" ::: "memory"); __builtin_amdgcn_sched_barrier(0);
#pragma unroll
            for (int ks = 0; ks < 4; ++ks)
#pragma unroll
                for (int mm = 0; mm < 2; ++mm) {
                    acc[0][mm] = __builtin_amdgcn_mfma_f32_16x16x32_bf16(af[ks][mm], bfr[0][ks], acc[0][mm], 0, 0, 0);
                    acc[1][mm] = __builtin_amdgcn_mfma_f32_16x16x32_bf16(af[ks][mm], bfr[1][ks], acc[1][mm], 0, 0, 0);
                    if (w == 0) acc[2][mm] = __builtin_amdgcn_mfma_f32_16x16x32_bf16(af[ks][mm], bfr[2][ks], acc[2][mm], 0, 0, 0);
                }
            __builtin_amdgcn_sched_barrier(0);
#pragma unroll
            for (int q = 0; q < 3; ++q) {
                if (q == 2 && (w != 0 || fr != 0)) continue;
                const int dv = (q == 2) ? ML_DV : 16 * (2 * w + q) + fr;
                const f32x4 x0 = acc[q][0], x1 = acc[q][1];
                u32x4 o; o.x = pk2(x0[0], x0[1]); o.y = pk2(x0[2], x0[3]); o.z = pk2(x1[0], x1[1]); o.w = pk2(x1[2], x1[3]);
                st16_wt(U + (size_t)dv * ML_DK + 32 * m2 + 8 * fq, o);
            }
        }
        __syncthreads();
    }
}

__device__ __forceinline__ void swa_mfma(Frame& F, int j) {
    constexpr int RS = 144, K_OFF = 0, V_OFF = 272 * RS;
    LAS unsigned char* L = F.lds;
    const gbf16* P = WSP(bf16_t, WS_PROJ);
    const gfloat* gq = FIN(11) + j * SW_DH; const gfloat* gk = FIN(12) + j * SW_DH;
    const int fr = F.lane & 15, fq = F.lane >> 4, w = F.wave;
    constexpr int NU = NBATCH * SW_KVH * (SEQ / 128);
    float* hsc = (float*)(F.sm + 81920) + w * 256;
    for (int it = 0; ; ++it) {
        const int u = mix_unit(F, it); if (u < 0) break;
        const int qb = u % (SEQ / 128), bk = u / (SEQ / 128), hk = bk % SW_KVH, b = bk / SW_KVH;
        const int q0 = qb * 128, k0 = q0 - 128;
        u32x4 tkw[4], tvw[4], qraw[4][2];
        int tl = F.tid; asm volatile("" : "+v"(tl));
        {
            const int tq_ = b * SEQ + q0 + 16 * w + (tl & 15), fq_ = (tl & 63) >> 4;
#pragma unroll
            for (int g = 0; g < 4; ++g) { qraw[g][0] = *(const GAS u32x4*)(P + (size_t)tq_ * SW_N + (hk * 4 + g) * SW_DH + 8 * fq_); qraw[g][1] = *(const GAS u32x4*)(P + (size_t)tq_ * SW_N + (hk * 4 + g) * SW_DH + 32 + 8 * fq_); }
        }
#pragma unroll
        for (int i = 0; i < 4; ++i) { const int idx = tl + NTHREADS * i, s = idx >> 3, d8 = (idx & 7) * 8, pos = k0 + s;
            tkw[i] = (u32x4){0u, 0u, 0u, 0u}; tvw[i] = (u32x4){0u, 0u, 0u, 0u};
            if (pos >= 0) { tkw[i] = *(const GAS u32x4*)(P + (size_t)(b * SEQ + pos) * SW_N + 1024 + hk * SW_DH + d8); tvw[i] = *(const GAS u32x4*)(P + (size_t)(b * SEQ + pos) * SW_N + 1280 + hk * SW_DH + d8); } }
        asm volatile("" ::: "memory");
#pragma unroll
        for (int i = 0; i < 4; ++i) {
            const int idx = tl + NTHREADS * i, s = idx >> 3, d8 = (idx & 7) * 8;
            const u32x4 kw = tkw[i], vw = tvw[i];
            float kf[8]; unpack8(kw, kf);
            float ss = 0.f;
#pragma unroll
            for (int jj = 0; jj < 8; ++jj) ss += kf[jj] * kf[jj];
            ss += shfl_xor_l(ss, 1, F.lane); ss += shfl_xor_l(ss, 2, F.lane); ss += shfl_xor_l(ss, 4, F.lane);
            const float r = rsqrtf(ss * (1.f / SW_DH) + EPS);
            const f32x4 g0 = *(const GAS f32x4*)(gk + d8), g1 = *(const GAS f32x4*)(gk + d8 + 4);
            u32x4 ko; ko.x = pk2(kf[0] * r * g0[0], kf[1] * r * g0[1]); ko.y = pk2(kf[2] * r * g0[2], kf[3] * r * g0[3]);
            ko.z = pk2(kf[4] * r * g1[0], kf[5] * r * g1[1]); ko.w = pk2(kf[6] * r * g1[2], kf[7] * r * g1[3]);
            *(u32x4*)(F.sm + K_OFF + s * RS + d8 * 2) = ko; *(u32x4*)(F.sm + V_OFF + s * RS + d8 * 2) = vw;
        }
        if (F.tid < 16 * 8 * 2) { const int s = 256 + ((F.tid >> 3) & 15), d8 = (F.tid & 7) * 8; unsigned z = 0u; asm volatile("" : "+v"(z)); *(u32x4*)(F.sm + ((F.tid >> 7) ? V_OFF : K_OFF) + s * RS + d8 * 2) = (u32x4){z, z, z, z}; }
        __syncthreads();
        const int tq = b * SEQ + q0 + 16 * w + fr;
        const f32x4 ga0 = *(const GAS f32x4*)(gq + 8 * fq), ga1 = *(const GAS f32x4*)(gq + 8 * fq + 4), gc0 = *(const GAS f32x4*)(gq + 32 + 8 * fq), gc1 = *(const GAS f32x4*)(gq + 32 + 8 * fq + 4);
        const int dq = fr - 4 * fq;
#pragma unroll
        for (int gp = 0; gp < 2; ++gp) {
            bf16x8 qf[2][2];
            float mx[2], sink[2];
#pragma unroll
            for (int e = 0; e < 2; ++e) {
                const int g = 2 * gp + e;
                float f0[8], f1[8];
                unpack8(qraw[g][0], f0);
                unpack8(qraw[g][1], f1);
                float ss = 0.f;
#pragma unroll
                for (int i = 0; i < 8; ++i) ss += f0[i] * f0[i] + f1[i] * f1[i];
                ss += shfl_xor_l(ss, 16, F.lane); ss += shfl_xor_l(ss, 32, F.lane);
                const float r = rsqrtf(ss * (1.f / SW_DH) + EPS) * 0.125f;
                u32x4 o0, o1;
                o0.x = pk2(f0[0] * r * ga0[0], f0[1] * r * ga0[1]); o0.y = pk2(f0[2] * r * ga0[2], f0[3] * r * ga0[3]); o0.z = pk2(f0[4] * r * ga1[0], f0[5] * r * ga1[1]); o0.w = pk2(f0[6] * r * ga1[2], f0[7] * r * ga1[3]);
                o1.x = pk2(f1[0] * r * gc0[0], f1[1] * r * gc0[1]); o1.y = pk2(f1[2] * r * gc0[2], f1[3] * r * gc0[3]); o1.z = pk2(f1[4] * r * gc1[0], f1[5] * r * gc1[1]); o1.w = pk2(f1[6] * r * gc1[2], f1[7] * r * gc1[3]);
                qf[e][0] = __builtin_bit_cast(bf16x8, o0); qf[e][1] = __builtin_bit_cast(bf16x8, o1);
                sink[e] = FIN(13)[j * SW_QH + hk * 4 + g]; mx[e] = sink[e];
            }
            f32x4 st[2][10];
#pragma unroll
            for (int half = 0; half < 2; ++half) {
                constexpr int NK0 = 5;
                const int kbase = half * NK0, nk = half ? 4 : 5;
                bf16x8 kf[5][2];
#pragma unroll
                for (int kk = 0; kk < 5; ++kk)
#pragma unroll
                    for (int ks = 0; ks < 2; ++ks) if (kk < nk) kf[kk][ks] = *(const LAS bf16x8*)(L + K_OFF + (16 * w + 16 * (kbase + kk) + fr) * RS + (32 * ks + 8 * fq) * 2);
                asm volatile("" ::: "memory"); __builtin_amdgcn_sched_barrier(0);
#pragma unroll
                for (int kk = 0; kk < 5; ++kk) if (kk < nk) {
#pragma unroll
                    for (int e = 0; e < 2; ++e) {
                        st[e][kbase + kk] = __builtin_amdgcn_mfma_f32_16x16x32_bf16(kf[kk][0], qf[e][0], (f32x4){0.f, 0.f, 0.f, 0.f}, 0, 0, 0);
                        st[e][kbase + kk] = __builtin_amdgcn_mfma_f32_16x16x32_bf16(kf[kk][1], qf[e][1], st[e][kbase + kk], 0, 0, 0); } }
                __builtin_amdgcn_sched_barrier(0);
            }
            float li[2];
#pragma unroll
            for (int e = 0; e < 2; ++e) {
#pragma unroll
                for (int r = 0; r < 4; ++r) { st[e][0][r] = (dq < r) ? st[e][0][r] : -INFINITY; st[e][8][r] = (dq >= r) ? st[e][8][r] : -INFINITY; }
                if (qb == 0) {
#pragma unroll
                    for (int kt = 0; kt < 9; ++kt)
#pragma unroll
                        for (int r = 0; r < 4; ++r) st[e][kt][r] = (16 * w + 16 * kt + 4 * fq + r >= 128) ? st[e][kt][r] : -INFINITY;
                }
#pragma unroll
                for (int kt = 0; kt < 9; ++kt)
#pragma unroll
                    for (int r = 0; r < 4; ++r) mx[e] = fmaxf(mx[e], st[e][kt][r]);
            }
#pragma unroll
            for (int e = 0; e < 2; ++e) mx[e] = fmaxf(mx[e], shfl_xor_l(mx[e], 16, F.lane));
#pragma unroll
            for (int e = 0; e < 2; ++e) mx[e] = fmaxf(mx[e], shfl_xor_l(mx[e], 32, F.lane));
            float l[2] = {0.f, 0.f};
#pragma unroll
            for (int e = 0; e < 2; ++e) {
#pragma unroll
                for (int kt = 0; kt < 9; ++kt)
#pragma unroll
                    for (int r = 0; r < 4; ++r) { const float p = __expf(st[e][kt][r] - mx[e]); st[e][kt][r] = p; l[e] += p; }
                st[e][9] = (f32x4){0.f, 0.f, 0.f, 0.f};
            }
#pragma unroll
            for (int e = 0; e < 2; ++e) l[e] += shfl_xor_l(l[e], 16, F.lane);
#pragma unroll
            for (int e = 0; e < 2; ++e) l[e] += shfl_xor_l(l[e], 32, F.lane);
#pragma unroll
            for (int e = 0; e < 2; ++e) li[e] = frcp(l[e] + __expf(sink[e] - mx[e]));
            f32x4 o[2][4];
#pragma unroll
            for (int e = 0; e < 2; ++e)
#pragma unroll
                for (int nt = 0; nt < 4; ++nt) o[e][nt] = (f32x4){0.f, 0.f, 0.f, 0.f};
#pragma unroll
            for (int kb = 0; kb < 5; ++kb) {
                bf16x8 pf[2];
#pragma unroll
                for (int e = 0; e < 2; ++e) { const f32x4 p0 = st[e][2 * kb] * li[e], p1 = st[e][2 * kb + 1] * li[e];
                    u32x4 pk; pk.x = pk2(p0[0], p0[1]); pk.y = pk2(p0[2], p0[3]); pk.z = pk2(p1[0], p1[1]); pk.w = pk2(p1[2], p1[3]);
                    pf[e] = __builtin_bit_cast(bf16x8, pk); }
                const LAS unsigned char* vb = L + V_OFF + (16 * w + 32 * kb + 4 * fq + (fr >> 2)) * RS + (16 * (fr & 3)) * 2;
                bf16x8 va[4];
#pragma unroll
                for (int nt = 0; nt < 4; ++nt) va[nt] = tr2(vb + 8 * nt, vb + 16 * RS + 8 * nt);
                asm volatile("" ::: "memory");
#pragma unroll
                for (int nt = 0; nt < 4; ++nt)
#pragma unroll
                    for (int e = 0; e < 2; ++e) o[e][nt] = __builtin_amdgcn_mfma_f32_16x16x32_bf16(va[nt], pf[e], o[e][nt], 0, 0, 0);
            }
#pragma unroll
            for (int e = 0; e < 2; ++e) {
                const int h = hk * 4 + 2 * gp + e;
                float hm = 0.f;
#pragma unroll
                for (int nt = 0; nt < 4; ++nt) hm = fmaxf(fmaxf(hm, fmaxf(fabsf(o[e][nt][0]), fabsf(o[e][nt][1]))), fmaxf(fabsf(o[e][nt][2]), fabsf(o[e][nt][3])));
                hm = fmaxf(hm, shfl_xor_l(hm, 16, F.lane)); hm = fmaxf(hm, shfl_xor_l(hm, 32, F.lane));
                const float sh = fmaxf(hm, 1e-30f), inv = 127.f * frcp(sh);
                if (fq == 0) hsc[h * 16 + fr] = sh;
                u32x4 q;
                q.x = pkq4(o[e][0][0] * inv, o[e][0][1] * inv, o[e][0][2] * inv, o[e][0][3] * inv); q.y = pkq4(o[e][1][0] * inv, o[e][1][1] * inv, o[e][1][2] * inv, o[e][1][3] * inv);
                q.z = pkq4(o[e][2][0] * inv, o[e][2][1] * inv, o[e][2][2] * inv, o[e][2][3] * inv); q.w = pkq4(o[e][3][0] * inv, o[e][3][1] * inv, o[e][3][2] * inv, o[e][3][3] * inv);
                *(GAS u32x4*)((GAS char*)WSP(unsigned char, WS_MIXQ) + (size_t)tq * D + h * SW_DH + 16 * fq) = q;
            }
        }
        if ((it & 3) == 3) mix_rescale<0>(F, tq, fr, fq, hsc);
        __syncthreads();
    }
}

__global__ void __launch_bounds__(NTHREADS, 2) mk_fwd(Args args) {
    extern __shared__ __attribute__((aligned(16))) unsigned char lds[];
    const int wave0 = __builtin_amdgcn_readfirstlane((int)threadIdx.x >> 6);
#define LEADER() (wave0 == 0 && lane_id_asm() == 0)
    volatile LAS unsigned* MISC = (volatile LAS unsigned*)((LAS unsigned char*)lds + MISC_OFF);
    if (threadIdx.x < 32) MISC[threadIdx.x] = 0u;
    __syncthreads();
    XcdBarrier bar; bar.bar = (gu32*)(args.ws + WS_CTL) + CW_BAR; bar.x = 0; bar.st = nullptr;
    if (!MK_PER_PHASE) bar = xcd_barrier_post((gu32*)(args.ws + WS_CTL) + CW_BAR, MISC + 8, LEADER());
    const int lo = args.ph_lo, hi = args.ph_hi;
    int ph = 0;
#define PHASE_BEGIN if (lo <= ph && ph < hi) { Frame F; frame_init(F, lds, wave0);
#define PHASE_END   if (ph + 1 < hi) { if (MK_PER_PHASE) { if (LEADER()) __hip_atomic_store((gu32*)(args.ws + WS_CTL) + CW_TMO, 0xBADBA0u, __ATOMIC_RELAXED, __HIP_MEMORY_SCOPE_AGENT); } else xcd_barrier(bar, LEADER()); } } ++ph;

    PHASE_BEGIN p0_prologue(F); PHASE_END
    PHASE_BEGIN p0b_modfinal(F); PHASE_END

    for (int layer = 0; layer < DEPTH; ++layer) {
        const int j = layer >> 1; const bool is_ml = (layer & 1) == 0;
        PHASE_BEGIN if (is_ml) normp_phase<1>(F, layer, 0, layer > 0); else normp_phase<0>(F, layer, 0, true); PHASE_END
        PHASE_BEGIN {
            const gbf16* Wt = (const gbf16*)(is_ml ? WSP(unsigned char, WS_WMLIN) + (size_t)j * ML_N * D : WSP(unsigned char, WS_WSWIN) + (size_t)j * SW_N * D);
            const int N = is_ml ? ML_N : SW_N;
            pg8::DenseOrder S; S.init(T, N, F.G, F.bid);
            pg8::EpiBf16Q E{WSP(bf16_t, WS_PROJ), N, is_ml ? 2 : 0, is_ml ? 4 : 0, 0.08838834764831845f, WSP(float, WS_SA), WSP(float, WS_SBIN) + (is_ml ? j * ML_N : 8192 + j * SW_N)};
            int Kq = D / 2; asm volatile("" : "+s"(Kq));
            pg8::gemm_phase<pg8::EpiBf16Q, pg8::DenseOrder, true, true>(F.lds, F.tid, WSP(bf16_t, WS_HNQ), Wt, Kq, S, E);
        } PHASE_END
        PHASE_BEGIN if (is_ml) ml_s1_mfma(F); else swa_mfma(F, j); PHASE_END
        if (is_ml) {
            PHASE_BEGIN ml_s2_phase(F); PHASE_END
            PHASE_BEGIN ml_s3_mfma(F, j); PHASE_END
        }
        PHASE_BEGIN {
            const gbf16* Wt = (const gbf16*)((is_ml ? WSP(unsigned char, WS_WMLOUT) : WSP(unsigned char, WS_WSWOUT)) + (size_t)j * D * D);
            pg8::DenseOrder S; S.init(T, D, F.G, F.bid);
            pg8::EpiResidQ E{WSP(bf16_t, WS_XB), WSP(float, WS_MOD) + (size_t)layer * 4 * 6144 + 2 * D, 6144, WSP(float, WS_SAM), WSP(float, WS_SBOUT) + (is_ml ? 0 : 2 * D) + j * D};
            int Kq = D / 2; asm volatile("" : "+s"(Kq));
            pg8::gemm_phase<pg8::EpiResidQ, pg8::DenseOrder, true, true>(F.lds, F.tid, WSP(bf16_t, WS_MIXQ), Wt, Kq, S, E);
        } PHASE_END
        PHASE_BEGIN normp_router(F, layer); PHASE_END
        PHASE_BEGIN {
            build_moe_tables(F, layer);
            const int nlab = (F.G % 8 == 0) ? 8 : 1;
            pg8::MoeOrder<3, true> S{(const LAS int*)(F.lds + TAB_BLK2E), (const LAS int*)(F.lds + TAB_BLKSTART), (const LAS int*)(F.lds + TAB_CNT), (const LAS int*)(F.lds + TAB_XBLK), WSP(unsigned, WS_LIST),
                                     ((const LAS int*)(F.lds + TAB_NBLK))[1] * 3, F.G / nlab, F.bid / nlab};
            pg8::EpiSwigluQ E{WSP(bf16_t, WS_H1), WSP(float, WS_SAE), WSP(float, WS_SB13) + (size_t)layer * NE * 768, (const LAS int*)(F.lds + TAB_BLK2E), (const LAS int*)(F.lds + TAB_BLKSTART)};
            int Kq = D / 2; asm volatile("" : "+s"(Kq));
            pg8::gemm_phase<pg8::EpiSwigluQ, pg8::MoeOrder<3, true>, true, true>(F.lds, F.tid, WSP(bf16_t, WS_HNQ), (const gbf16*)(WSP(unsigned char, WS_W13) + (size_t)layer * NE * 768 * D), Kq, S, E);
        } PHASE_END
        PHASE_BEGIN {
            build_moe_tables(F, layer);
            const int nlab = (F.G % 8 == 0) ? 8 : 1;
            pg8::MoeOrder<4, false> S{(const LAS int*)(F.lds + TAB_BLK2E), (const LAS int*)(F.lds + TAB_BLKSTART), (const LAS int*)(F.lds + TAB_CNT), (const LAS int*)(F.lds + TAB_XBLK), WSP(unsigned, WS_LIST),
                                      ((const LAS int*)(F.lds + TAB_NBLK))[1] * 4, F.G / nlab, F.bid / nlab};
            pg8::EpiYsQ E{WSP(unsigned char, WS_YS), WSP(float, WS_YSS)};
            int Kr = DE; asm volatile("" : "+s"(Kr));
            pg8::gemm_phase<pg8::EpiYsQ, pg8::MoeOrder<4, false>, true>(F.lds, F.tid, WSP(bf16_t, WS_H1), WSP(bf16_t, WS_W2) + (size_t)layer * NE * D * DE, Kr, S, E);
        } PHASE_END
    }
    PHASE_BEGIN final_phase(F); PHASE_END
#undef PHASE_BEGIN
#undef PHASE_END
}
constexpr int N_PHASES = 2 + (DEPTH / 2) * (9 + 7) + 1;

extern "C" void kernel_launch(void* const* d_in, const int* in_sizes, int n_in, void* d_out, int out_size, void* d_ws, size_t ws_size, hipStream_t stream) {
    static int grid = 0;
    if (grid == 0) {
        if (n_in != 22 || out_size != T * D || ws_size < WS_END) { fprintf(stderr, "kernel_launch: unexpected shapes (n_in %d, out %d, ws %zu < %zu); nothing launched\n", n_in, out_size, ws_size, (size_t)WS_END); grid = -1; return; }
        int dev = 0, cus = 0, per_cu = 0;
        if (hipGetDevice(&dev) != hipSuccess || hipDeviceGetAttribute(&cus, hipDeviceAttributeMultiprocessorCount, dev) != hipSuccess) { grid = -1; return; }
        if (hipFuncSetAttribute((const void*)mk_fwd, hipFuncAttributeMaxDynamicSharedMemorySize, LDS_BYTES) != hipSuccess) { fprintf(stderr, "kernel_launch: hipFuncSetAttribute failed\n"); grid = -1; return; }
        if (hipOccupancyMaxActiveBlocksPerMultiprocessor(&per_cu, (const void*)mk_fwd, NTHREADS, LDS_BYTES) != hipSuccess || per_cu < 1)
            fprintf(stderr, "kernel_launch: note: occupancy query reports %d workgroups per CU\n", per_cu);
        (void)hipGetLastError();
        grid = cus;
    }
    if (grid < 0) return;
    if (hipMemsetAsync((char*)d_ws + WS_CTL, 0, CTL_ZERO_BYTES, stream) != hipSuccess) { fprintf(stderr, "kernel_launch: memset failed\n"); return; }
    Args a{};
    for (int i = 0; i < 22; ++i) a.in[i] = (const float*)d_in[i];
    a.out = (float*)d_out; a.ws = (unsigned char*)d_ws;
#if MK_PER_PHASE
    for (int p = 0; p < N_PHASES; ++p) { a.ph_lo = p; a.ph_hi = p + 1; hipLaunchKernelGGL(mk_fwd, dim3(grid), dim3(NTHREADS), LDS_BYTES, stream, a); }
#else
    a.ph_lo = 0; a.ph_hi = N_PHASES;
    hipLaunchKernelGGL(mk_fwd, dim3(grid), dim3(NTHREADS), LDS_BYTES, stream, a);
#endif
    const hipError_t le = hipPeekAtLastError();
    if (le != hipSuccess) fprintf(stderr, "kernel_launch: launch failed: %s\n", hipGetErrorName(le));
}
```
